# Optimizing an MI355X kernel written in HIP

```python
import math
import jax, jax.numpy as jnp
from jax import lax
import numpy as np

D_MODEL = 4096
BATCH = 4
SEQ = 4096
DEPTH = 1

CHUNK = 64
EPS = 1e-6
D_MIX = D_MODEL
D_S5 = D_MIX // 2
S5_GROUP = 16
S5_GROUPS = D_S5 // S5_GROUP
S5_STATE = 64
DT_MIN = 1e-3
DT_MAX = 1e-1
D_GM = D_MIX - D_S5
GM_HEADS = 8
GM_HEAD_DIM = D_GM // GM_HEADS
GM_BLOCK = 128
PEER_HEADS = 8
PEER_KEYS = 128
PEER_EXPERTS = PEER_KEYS * PEER_KEYS
PEER_QDIM = 256
PEER_TOPK = 16
PEER_TOKEN_BLOCK = 128

kernel_name = "hymba_s5_gmlp_peer_block"


def _rmsnorm(x, g):
    xf = x.astype(jnp.float32)
    y = xf * lax.rsqrt(jnp.mean(xf * xf, axis=-1, keepdims=True) + EPS)
    return (y * g.astype(jnp.float32)).astype(x.dtype)


def _layernorm(x, g, b):
    xf = x.astype(jnp.float32)
    mu = jnp.mean(xf, axis=-1, keepdims=True)
    xc = xf - mu
    y = xc * lax.rsqrt(jnp.mean(xc * xc, axis=-1, keepdims=True) + EPS)
    return (y * g.astype(jnp.float32) + b.astype(jnp.float32)).astype(x.dtype)


def _complex_affine_combine(left, right):
    a1r, a1i, b1r, b1i = left
    a2r, a2i, b2r, b2i = right
    ar = a2r * a1r - a2i * a1i
    ai = a2r * a1i + a2i * a1r
    br = a2r * b1r - a2i * b1i + b2r
    bi = a2r * b1i + a2i * b1r + b2i
    return (ar, ai, br, bi)


def _s5_mixer(u, a_re, a_im, log_dt, b_re, b_im, c_re, c_im, d_skip, w_glu):
    bsz, seq, _ = u.shape
    uf = u.astype(jnp.float32).reshape(bsz, seq, S5_GROUPS, S5_GROUP)
    dt = jnp.exp(log_dt.astype(jnp.float32))[:, None]
    lr = a_re.astype(jnp.float32)
    li = a_im.astype(jnp.float32)
    mag = jnp.exp(lr * dt)
    ang = li * dt
    abar_r = mag * jnp.cos(ang)
    abar_i = mag * jnp.sin(ang)
    nr = abar_r - 1.0
    ni = abar_i
    den = lr * lr + li * li
    coef_r = (nr * lr + ni * li) / den
    coef_i = (ni * lr - nr * li) / den
    br = b_re.astype(jnp.float32)
    bi = b_im.astype(jnp.float32)
    bbar_r = coef_r[..., None] * br - coef_i[..., None] * bi
    bbar_i = coef_r[..., None] * bi + coef_i[..., None] * br
    bu_r = jnp.einsum('blgc,gpc->lbgp', uf, bbar_r)
    bu_i = jnp.einsum('blgc,gpc->lbgp', uf, bbar_i)
    a_r = jnp.broadcast_to(abar_r[None, None], (seq, 1, S5_GROUPS, S5_STATE))
    a_i = jnp.broadcast_to(abar_i[None, None], (seq, 1, S5_GROUPS, S5_STATE))
    _, _, s_r, s_i = lax.associative_scan(_complex_affine_combine, (a_r, a_i, bu_r, bu_i), axis=0)
    y = (jnp.einsum('lbgp,gcp->blgc', s_r, c_re.astype(jnp.float32))
         - jnp.einsum('lbgp,gcp->blgc', s_i, c_im.astype(jnp.float32)))
    y = (y + d_skip.astype(jnp.float32).reshape(S5_GROUPS, S5_GROUP) * uf).reshape(bsz, seq, D_S5)
    y = jax.nn.gelu(y).astype(u.dtype)
    return y * jax.nn.sigmoid(y @ w_glu)


def _gmlp_mixer(z, ln_g, ln_b, w_s, b_s):
    bsz, seq, _ = z.shape
    z = jax.nn.gelu(z)
    u, v = jnp.split(z, 2, axis=-1)
    v = _layernorm(v, ln_g, ln_b)
    nblk = seq // GM_BLOCK
    v = v.reshape(bsz, nblk, GM_BLOCK, GM_HEADS, GM_HEAD_DIM)
    pos = jnp.arange(GM_BLOCK)
    mask = (pos[None, :] // CHUNK) <= (pos[:, None] // CHUNK)
    w = jnp.where(mask[None], w_s, 0.0)
    gate = jnp.einsum('hij,bnjhd->bnihd', w, v) + jnp.transpose(b_s)[None, None, :, :, None]
    return u * gate.reshape(bsz, seq, D_GM)


def _peer(x, w_q, keys_1, keys_2, expert_down, expert_up):
    bsz, seq, dim = x.shape
    q = (x @ w_q).reshape(bsz, seq, PEER_HEADS, 2, PEER_QDIM // 2)
    s1 = jnp.einsum('blhd,nd->blhn', q[..., 0, :], keys_1).astype(jnp.float32)
    s2 = jnp.einsum('blhd,nd->blhn', q[..., 1, :], keys_2).astype(jnp.float32)
    v1, i1 = lax.top_k(s1, PEER_TOPK)
    v2, i2 = lax.top_k(s2, PEER_TOPK)
    cand = (v1[..., :, None] + v2[..., None, :]).reshape(bsz, seq, PEER_HEADS, PEER_TOPK * PEER_TOPK)
    sc, ci = lax.top_k(cand, PEER_TOPK)
    e1 = jnp.take_along_axis(i1, ci // PEER_TOPK, axis=-1)
    e2 = jnp.take_along_axis(i2, ci % PEER_TOPK, axis=-1)
    expert = e1 * PEER_KEYS + e2
    gates = jax.nn.softmax(sc, axis=-1).astype(x.dtype)
    nblk = (bsz * seq) // PEER_TOKEN_BLOCK
    hk = PEER_HEADS * PEER_TOPK
    xb = x.reshape(nblk, PEER_TOKEN_BLOCK, dim)
    eb = expert.reshape(nblk, PEER_TOKEN_BLOCK, hk)
    gb = gates.reshape(nblk, PEER_TOKEN_BLOCK, hk)

    def block(args):
        xt, et, gt = args
        u = jnp.take(expert_down, et, axis=0)
        act = jax.nn.gelu(jnp.einsum('td,ted->te', xt, u)) * gt
        v = jnp.take(expert_up, et, axis=0)
        return jnp.einsum('te,ted->td', act, v)

    out = lax.map(block, (xb, eb, gb))
    return out.reshape(bsz, seq, dim)


def setup_inputs(seed: int = 0) -> dict:
    key = jax.random.key(seed)
    ks = jax.random.split(key, 27)
    f32 = jnp.float32
    nrm = lambda k, shape, s: jax.random.normal(k, shape, f32) * s
    gain = lambda k, shape: 1.0 + 0.02 * jax.random.normal(k, shape, f32)
    n_idx = jnp.arange(S5_STATE, dtype=f32)
    return {
        "x": nrm(ks[0], (BATCH, SEQ, D_MODEL), 1.0),
        "norm_mix_g": gain(ks[1], (DEPTH, D_MODEL)),
        "w_in": nrm(ks[2], (DEPTH, D_MODEL, D_S5 + 2 * D_GM), D_MODEL ** -0.5),
        "s5_a_re": -0.5 + 0.01 * jax.random.normal(ks[3], (DEPTH, S5_GROUPS, S5_STATE), f32),
        "s5_a_im": math.pi * n_idx + 0.01 * jax.random.normal(ks[4], (DEPTH, S5_GROUPS, S5_STATE), f32),
        "s5_log_dt": jax.random.uniform(ks[5], (DEPTH, S5_GROUPS), f32, math.log(DT_MIN), math.log(DT_MAX)),
        "s5_b_re": nrm(ks[6], (DEPTH, S5_GROUPS, S5_STATE, S5_GROUP), (2 * S5_GROUP) ** -0.5),
        "s5_b_im": nrm(ks[7], (DEPTH, S5_GROUPS, S5_STATE, S5_GROUP), (2 * S5_GROUP) ** -0.5),
        "s5_c_re": nrm(ks[8], (DEPTH, S5_GROUPS, S5_GROUP, S5_STATE), S5_STATE ** -0.5),
        "s5_c_im": nrm(ks[9], (DEPTH, S5_GROUPS, S5_GROUP, S5_STATE), S5_STATE ** -0.5),
        "s5_d": nrm(ks[10], (DEPTH, D_S5), 0.5),
        "s5_w_glu": nrm(ks[11], (DEPTH, D_S5, D_S5), D_S5 ** -0.5),
        "gm_ln_g": gain(ks[12], (DEPTH, D_GM)),
        "gm_ln_b": nrm(ks[13], (DEPTH, D_GM), 0.02),
        "gm_w_s": nrm(ks[14], (DEPTH, GM_HEADS, GM_BLOCK, GM_BLOCK), GM_BLOCK ** -0.5),
        "gm_b_s": gain(ks[15], (DEPTH, GM_HEADS, GM_BLOCK)),
        "norm_s5_out_g": gain(ks[16], (DEPTH, D_S5)),
        "norm_gm_out_g": gain(ks[17], (DEPTH, D_GM)),
        "w_out": nrm(ks[18], (DEPTH, D_MIX, D_MODEL), D_MIX ** -0.5),
        "norm_ffn_g": gain(ks[19], (DEPTH, D_MODEL)),
        "peer_w_q": nrm(ks[20], (DEPTH, D_MODEL, PEER_HEADS * PEER_QDIM), D_MODEL ** -0.5),
        "peer_keys_1": nrm(ks[21], (DEPTH, PEER_KEYS, PEER_QDIM // 2), (PEER_QDIM // 2) ** -0.5),
        "peer_keys_2": nrm(ks[22], (DEPTH, PEER_KEYS, PEER_QDIM // 2), (PEER_QDIM // 2) ** -0.5),
        "peer_down": nrm(ks[23], (DEPTH, PEER_EXPERTS, D_MODEL), D_MODEL ** -0.5),
        "peer_up": nrm(ks[24], (DEPTH, PEER_EXPERTS, D_MODEL), PEER_HEADS ** -0.5),
        "norm_final_g": gain(ks[25], (D_MODEL,)),
    }


def reference(x, norm_mix_g, w_in, s5_a_re, s5_a_im, s5_log_dt, s5_b_re, s5_b_im, s5_c_re, s5_c_im,
              s5_d, s5_w_glu, gm_ln_g, gm_ln_b, gm_w_s, gm_b_s, norm_s5_out_g, norm_gm_out_g, w_out,
              norm_ffn_g, peer_w_q, peer_keys_1, peer_keys_2, peer_down, peer_up, norm_final_g):
    h = x
    for i in range(DEPTH):
        a = _rmsnorm(h, norm_mix_g[i])
        z = a @ w_in[i]
        y_s5 = _s5_mixer(z[..., :D_S5], s5_a_re[i], s5_a_im[i], s5_log_dt[i], s5_b_re[i], s5_b_im[i],
                         s5_c_re[i], s5_c_im[i], s5_d[i], s5_w_glu[i])
        y_gm = _gmlp_mixer(z[..., D_S5:], gm_ln_g[i], gm_ln_b[i], gm_w_s[i], gm_b_s[i])
        mixed = jnp.concatenate([_rmsnorm(y_s5, norm_s5_out_g[i]), _rmsnorm(y_gm, norm_gm_out_g[i])], axis=-1)
        h = h + mixed @ w_out[i]
        h = h + _peer(_rmsnorm(h, norm_ffn_g[i]), peer_w_q[i], peer_keys_1[i], peer_keys_2[i],
                      peer_down[i], peer_up[i])
    return _rmsnorm(h, norm_final_g)
```

```cpp
#include <hip/hip_runtime.h>
#include <hip/hip_cooperative_groups.h>
#include <cstdio>
#include <cstdint>
namespace cg = cooperative_groups;
namespace pg8 {
#define PG8_LAS __attribute__((address_space(3)))
typedef unsigned short bf16_t;
typedef short bf16x8 __attribute__((ext_vector_type(8)));
typedef float f32x4 __attribute__((ext_vector_type(4)));
typedef unsigned u32x4 __attribute__((ext_vector_type(4)));
constexpr int BM = 256, BK = 64, HALF = 128, HTB = HALF * BK * 2  , STAGE_BYTES = 8 * HTB, NXCD = 8, WGM = 8;

__host__ __device__ __forceinline__ int lds_byte(int r, int c) { const int st = (r >> 4) * 2 + (c >> 5), rr = r & 15, cc = c & 31, ob = rr * 64 + cc * 2; return st * 1024 + (ob ^ (((ob >> 9) & 1) << 5)); }
__host__ __device__ __forceinline__ void stage_rc(int b, int& R, int& C) { const int st = b / 1024, sb = b % 1024, swz = sb ^ (((sb >> 9) & 1) << 5); R = (st >> 1) * 16 + swz / 64; C = (st & 1) * 32 + (swz % 64) / 2; }
__host__ __device__ __forceinline__ int perm32(int rho) { const int n = rho >> 4, i = rho & 15; return 8 * (i >> 2) + 4 * n + (i & 3); }

struct Unit { int pm, pn; };
struct Gemm { const bf16_t* A; const bf16_t* Bt; int M, N, K; };

struct StaticOrder {
    int nM, nN, nwg, G, c;
    __host__ __device__ void init(int M, int N, int G_, int c_) { nM = M / BM; nN = N / BM; nwg = nM * nN; G = G_; c = c_; }
    __host__ __device__ bool next(int i, Unit& u) const {
        const long L = (long)i * G + c; if (L >= nwg) return false;
        int wgid = (int)L; { const int q = nwg / NXCD, r = nwg % NXCD, xcd = wgid % NXCD, off = wgid / NXCD; wgid = (xcd < r ? xcd * (q + 1) : r * (q + 1) + (xcd - r) * q) + off; }
        const int nig = WGM * nN, gid = wgid / nig, fm = gid * WGM, gsz = (nM - fm) < WGM ? (nM - fm) : WGM;
        u.pm = fm + ((wgid % nig) % gsz); u.pn = (wgid % nig) / gsz; return true;
    }
    __device__ __forceinline__ void a_ready(const Unit&) const {}
    __device__ __forceinline__ void done(const Unit&) const {}
};
__device__ __forceinline__ unsigned cvt_pk_bf16(float lo, float hi) { unsigned r; asm volatile("v_cvt_pk_bf16_f32 %0, %1, %2" : "=v"(r) : "v"(lo), "v"(hi)); return r; }
template <class Epi, class Sched, bool ALIGN_EPI = false, bool SP2 = false>
__device__ __forceinline__ void gemm_phase(PG8_LAS unsigned char* lds, const Gemm g, const Sched& S, const Epi& E) {
    const int tid = threadIdx.x, wid = __builtin_amdgcn_readfirstlane(tid >> 6), lane = tid & 63, wr = wid >> 2, wc = wid & 3, fr = lane & 15, fq = lane >> 4;
    const int K = g.K, nt = K / BK;
    unsigned voffA[2], voffB[2];
#pragma unroll
    for (int i = 0; i < 2; ++i) { int R, C; stage_rc(tid * 16 + i * 8192, R, C); const int Rb = Epi::PERM ? ((R & ~31) + perm32(R & 31)) : R;
        voffA[i] = (unsigned)(R * K + C) * 2u; voffB[i] = (unsigned)(Rb * K + C) * 2u; }
    const size_t kstep = (size_t)(BK * 2);
    const size_t hstep = (size_t)HALF * K * 2;
    const size_t tstep = 2 * hstep;
    const unsigned ldsw = (unsigned)wid * 1024u;
    const int aoff = lds_byte(wr * 64 + fr, fq * 8), boff = lds_byte(wc * 32 + fr, fq * 8);
#define PG8_SA(b, h) (((b) * 2 + (h)) * HTB)
#define PG8_SB(b, h) ((4 + (b) * 2 + (h)) * HTB)
#define PG8_STAGE(bufoff, gbase, voff) do { _Pragma("unroll") for (int _i = 0; _i < 2; ++_i) \
        __builtin_amdgcn_global_load_lds((const unsigned*)((const char*)(gbase) + (voff)[_i]), (PG8_LAS unsigned*)(lds + (bufoff) + ldsw + _i * 8192), 16, 0, 0); } while (0)
#define PG8_LDA(dst, b, h) do { _Pragma("unroll") for (int m = 0; m < 4; ++m) _Pragma("unroll") for (int k = 0; k < 2; ++k) dst[m][k] = *(const PG8_LAS bf16x8*)(lds + PG8_SA(b, h) + aoff + m * 2048 + k * 1024); } while (0)
#define PG8_LDB(dst, b, h) do { _Pragma("unroll") for (int n = 0; n < 2; ++n) _Pragma("unroll") for (int k = 0; k < 2; ++k) dst[n][k] = *(const PG8_LAS bf16x8*)(lds + PG8_SB(b, h) + boff + n * 2048 + k * 1024); } while (0)
#define PG8_MMA(ai, bj, At, Bt) do { __builtin_amdgcn_s_setprio(1); _Pragma("unroll") for (int m = 0; m < 4; ++m) _Pragma("unroll") for (int n = 0; n < 2; ++n) _Pragma("unroll") for (int k = 0; k < 2; ++k) \
        acc[ai][bj][m][n] = __builtin_amdgcn_mfma_f32_16x16x32_bf16(Bt[n][k], At[m][k], acc[ai][bj][m][n], 0, 0, 0); __builtin_amdgcn_s_setprio(0); } while (0)
#define PG8_WAIT_V(n) asm volatile("s_waitcnt vmcnt(" #n ")" ::: "memory")
#define PG8_WAIT_L(n) asm volatile("s_waitcnt lgkmcnt(" #n ")" ::: "memory")
#define PG8_BAR __builtin_amdgcn_s_barrier()
#define PG8_SCHED __builtin_amdgcn_sched_barrier(0)
    Unit cur, nxt; int ui = 0;
    if (!S.next(0, cur)) return;
    f32x4 acc[2][2][4][2];
#pragma unroll
    for (int a = 0; a < 2; ++a)
#pragma unroll
        for (int b = 0; b < 2; ++b)
#pragma unroll
            for (int m = 0; m < 4; ++m)
#pragma unroll
                for (int n = 0; n < 2; ++n) acc[a][b][m][n] = (f32x4){0.f, 0.f, 0.f, 0.f};
    bf16x8 At[4][2], B0[2][2], B1[2][2];
    const char* cA = (const char*)g.A + (size_t)cur.pm * tstep; const char* cB = (const char*)g.Bt + (size_t)cur.pn * tstep;
    S.a_ready(cur);
    if constexpr (SP2) {
        PG8_STAGE(PG8_SB(0, 0), cB, voffB); PG8_STAGE(PG8_SB(0, 1), cB + hstep, voffB); PG8_STAGE(PG8_SA(0, 0), cA, voffA); PG8_STAGE(PG8_SA(0, 1), cA + hstep, voffA);
        if (wr == 1) PG8_BAR;
        PG8_WAIT_V(2); PG8_BAR;
        PG8_STAGE(PG8_SB(1, 0), cB + kstep, voffB); PG8_STAGE(PG8_SA(1, 0), cA + kstep, voffA); PG8_STAGE(PG8_SB(1, 1), cB + hstep + kstep, voffB);
        PG8_WAIT_V(6); PG8_BAR;
    } else {
        PG8_STAGE(PG8_SB(0, 0), cB, voffB); PG8_STAGE(PG8_SA(0, 0), cA, voffA); PG8_STAGE(PG8_SB(0, 1), cB + hstep, voffB); PG8_STAGE(PG8_SA(0, 1), cA + hstep, voffA);
        if (wr == 1) PG8_BAR;
        PG8_WAIT_V(4); PG8_BAR;
        PG8_STAGE(PG8_SB(1, 0), cB + kstep, voffB); PG8_STAGE(PG8_SA(1, 0), cA + kstep, voffA); PG8_STAGE(PG8_SB(1, 1), cB + hstep + kstep, voffB);
        PG8_WAIT_V(6); PG8_BAR;
    }
    for (;;) {
        const bool has_next = S.next(ui + 1, nxt);
        const char* nA = has_next ? (const char*)g.A + (size_t)nxt.pm * tstep : cA; const char* nB = has_next ? (const char*)g.Bt + (size_t)nxt.pn * tstep : cB;
        for (int t = 0; t < nt; t += 2) {
            if constexpr (Epi::MIDSCALE) { if (t == nt / 2) E.midscale(acc, cur, wr, fr); }
            const bool last = (t == nt - 2);
            const char* a1 = cA + (size_t)(t + 1) * kstep;
            const char* a2 = last ? nA : cA + (size_t)(t + 2) * kstep; const char* b2 = last ? nB : cB + (size_t)(t + 2) * kstep;
            const char* a3 = a2 + kstep; const char* b3 = b2 + kstep;
            if (last && has_next) S.a_ready(nxt);
            if constexpr (SP2) {
            PG8_LDB(B0, 0, 0); PG8_LDB(B1, 0, 1); PG8_SCHED; PG8_LDA(At, 0, 0); PG8_STAGE(PG8_SA(1, 1), a1 + hstep, voffA);
            PG8_WAIT_V(8); PG8_WAIT_L(0); PG8_BAR; PG8_MMA(0, 0, At, B0); PG8_MMA(0, 1, At, B1); PG8_BAR; PG8_SCHED;
            PG8_LDA(At, 0, 1); PG8_STAGE(PG8_SB(0, 0), b2, voffB); PG8_STAGE(PG8_SB(0, 1), b2 + hstep, voffB); PG8_STAGE(PG8_SA(0, 0), a2, voffA);
            PG8_WAIT_V(8); PG8_WAIT_L(0); PG8_BAR; PG8_MMA(1, 0, At, B0); PG8_MMA(1, 1, At, B1); PG8_BAR; PG8_SCHED;
            PG8_LDB(B0, 1, 0); PG8_LDB(B1, 1, 1); PG8_SCHED; PG8_LDA(At, 1, 0); PG8_STAGE(PG8_SA(0, 1), a2 + hstep, voffA);
            PG8_WAIT_V(8); PG8_WAIT_L(0); PG8_BAR; PG8_MMA(0, 0, At, B0); PG8_MMA(0, 1, At, B1); PG8_BAR; PG8_SCHED;
            PG8_LDA(At, 1, 1); PG8_STAGE(PG8_SB(1, 0), b3, voffB); PG8_STAGE(PG8_SB(1, 1), b3 + hstep, voffB); PG8_STAGE(PG8_SA(1, 0), a3, voffA);
            PG8_WAIT_V(8); PG8_WAIT_L(0); PG8_BAR; PG8_MMA(1, 0, At, B0); PG8_MMA(1, 1, At, B1); PG8_BAR; PG8_SCHED;
            } else {
            PG8_LDB(B0, 0, 0); PG8_SCHED; PG8_LDA(At, 0, 0); PG8_STAGE(PG8_SA(1, 1), a1 + hstep, voffA);
            PG8_WAIT_L(8); PG8_BAR; PG8_WAIT_L(0); PG8_MMA(0, 0, At, B0); PG8_BAR; PG8_SCHED;
            PG8_LDB(B1, 0, 1); PG8_STAGE(PG8_SB(0, 0), b2, voffB);
            PG8_BAR; PG8_WAIT_L(0); PG8_MMA(0, 1, At, B1); PG8_BAR;
            PG8_LDA(At, 0, 1); PG8_STAGE(PG8_SA(0, 0), a2, voffA);
            PG8_BAR; PG8_WAIT_L(0); PG8_MMA(1, 0, At, B0); PG8_BAR; PG8_SCHED;
            PG8_STAGE(PG8_SB(0, 1), b2 + hstep, voffB);
            PG8_WAIT_V(6); PG8_BAR; PG8_MMA(1, 1, At, B1); PG8_BAR;
            PG8_LDB(B0, 1, 0); PG8_SCHED; PG8_LDA(At, 1, 0); PG8_STAGE(PG8_SA(0, 1), a2 + hstep, voffA);
            PG8_WAIT_L(8); PG8_BAR; PG8_WAIT_L(0); PG8_MMA(0, 0, At, B0); PG8_BAR; PG8_SCHED;
            PG8_LDB(B1, 1, 1); PG8_STAGE(PG8_SB(1, 0), b3, voffB);
            PG8_BAR; PG8_WAIT_L(0); PG8_MMA(0, 1, At, B1); PG8_BAR;
            PG8_LDA(At, 1, 1); PG8_STAGE(PG8_SA(1, 0), a3, voffA);
            PG8_BAR; PG8_WAIT_L(0); PG8_MMA(1, 0, At, B0); PG8_BAR; PG8_SCHED;
            PG8_STAGE(PG8_SB(1, 1), b3 + hstep, voffB);
            PG8_WAIT_V(6); PG8_BAR; PG8_MMA(1, 1, At, B1); PG8_BAR;
            }
        }
        if constexpr (ALIGN_EPI) { if (wr == 0) PG8_BAR; }
        if constexpr (!Epi::AFTER_DRAIN) { E(acc, cur, wr, wc, fr, fq); S.done(cur); }
        if (!has_next) break;
#pragma unroll
        for (int a = 0; a < 2; ++a)
#pragma unroll
            for (int b = 0; b < 2; ++b)
#pragma unroll
                for (int m = 0; m < 4; ++m)
#pragma unroll
                    for (int n = 0; n < 2; ++n) acc[a][b][m][n] = (f32x4){0.f, 0.f, 0.f, 0.f};
        cur = nxt; cA = nA; cB = nB; ++ui;
        if constexpr (ALIGN_EPI) { if (wr == 1) PG8_BAR; }
    }
    PG8_WAIT_V(0);
    if constexpr (!ALIGN_EPI) { if (wr == 0) PG8_BAR; }
    PG8_BAR;
    if constexpr (Epi::AFTER_DRAIN) { E.fused(acc, cur, wr, wc, fr, fq, lds, wid, lane); S.done(cur); }
#undef PG8_SA
#undef PG8_SB
#undef PG8_STAGE
#undef PG8_LDA
#undef PG8_LDB
#undef PG8_MMA
#undef PG8_WAIT_V
#undef PG8_WAIT_L
#undef PG8_BAR
#undef PG8_SCHED
}

typedef float f32x2v __attribute__((ext_vector_type(2)));
__device__ __forceinline__ float gelu_t(float x) {
    const float u = x * (1.5957691216f + 0.0713548163f * x * x);
    const float e = __builtin_amdgcn_exp2f(-1.4426950409f * u);
    return x * __builtin_amdgcn_rcpf(1.0f + e);
}
__device__ __forceinline__ float sigmoid_f(float x) { return __builtin_amdgcn_rcpf(1.0f + __builtin_amdgcn_exp2f(-1.4426950409f * x)); }
__device__ __forceinline__ float bf_lo(unsigned w) { return __uint_as_float(w << 16); }
__device__ __forceinline__ float bf_hi(unsigned w) { return __uint_as_float(w & 0xffff0000u); }

struct EpiZ {
    static constexpr bool PERM = true, AFTER_DRAIN = false, MIDSCALE = false;
    bf16_t* Z; bf16_t* ZS5; f32x2v* statsV;
    __device__ __forceinline__ void operator()(const f32x4 (&acc)[2][2][4][2], const Unit& u, int wr, int wc, int fr, int fq) const {
        const int row0 = u.pm * BM + wr * 64 + fr, col0 = u.pn * BM + wc * 32 + 8 * fq;
        const bool act = u.pn >= 8, st = u.pn >= 16;
#pragma unroll
        for (int ai = 0; ai < 2; ++ai)
#pragma unroll
            for (int m = 0; m < 4; ++m) {
                const int row = row0 + ai * HALF + m * 16; float s = 0.f, q = 0.f;
#pragma unroll
                for (int bj = 0; bj < 2; ++bj) { f32x4 v0 = acc[ai][bj][m][0], v1 = acc[ai][bj][m][1];
                    if (act) {
#pragma unroll
                        for (int j = 0; j < 4; ++j) { v0[j] = gelu_t(v0[j]); v1[j] = gelu_t(v1[j]); }
                    }
#pragma unroll
                    for (int j = 0; j < 4; ++j) { s += v0[j] + v1[j]; q += v0[j] * v0[j] + v1[j] * v1[j]; }
                    u32x4 w; w.x = cvt_pk_bf16(v0[0], v0[1]); w.y = cvt_pk_bf16(v0[2], v0[3]); w.z = cvt_pk_bf16(v1[0], v1[1]); w.w = cvt_pk_bf16(v1[2], v1[3]);
                    const int col = col0 + bj * HALF;
                    if (act) *(u32x4*)(Z + (size_t)row * 4096 + (col - 2048)) = w; else *(u32x4*)(ZS5 + ((size_t)(col >> 4) * 16384 + row) * 16 + (col & 8)) = w; }
                if (st) { s += __shfl_xor(s, 16); s += __shfl_xor(s, 32); q += __shfl_xor(q, 16); q += __shfl_xor(q, 32);
                    if (fq == 0) statsV[(size_t)row * 32 + (u.pn - 16) * 4 + wc] = (f32x2v){s, q}; }
            }
    }
};
struct EpiGlu {
    static constexpr bool PERM = true, AFTER_DRAIN = false, MIDSCALE = false;
    const bf16_t* Y; bf16_t* MIX; float* SA;
    __device__ __forceinline__ void operator()(const f32x4 (&acc)[2][2][4][2], const Unit& u, int wr, int wc, int fr, int fq) const {
        const int row0 = u.pm * BM + wr * 64 + fr, col0 = u.pn * BM + wc * 32 + 8 * fq;
#pragma unroll
        for (int ai = 0; ai < 2; ++ai)
#pragma unroll
            for (int m = 0; m < 4; ++m) {
                const int row = row0 + ai * HALF + m * 16; float q = 0.f;
#pragma unroll
                for (int bj = 0; bj < 2; ++bj) { const f32x4 g0 = acc[ai][bj][m][0], g1 = acc[ai][bj][m][1];
                    const u32x4 yw = *(const u32x4*)(Y + (size_t)row * 2048 + col0 + bj * HALF);
                    float o[8];
                    o[0] = bf_lo(yw.x) * sigmoid_f(g0[0]); o[1] = bf_hi(yw.x) * sigmoid_f(g0[1]); o[2] = bf_lo(yw.y) * sigmoid_f(g0[2]); o[3] = bf_hi(yw.y) * sigmoid_f(g0[3]);
                    o[4] = bf_lo(yw.z) * sigmoid_f(g1[0]); o[5] = bf_hi(yw.z) * sigmoid_f(g1[1]); o[6] = bf_lo(yw.w) * sigmoid_f(g1[2]); o[7] = bf_hi(yw.w) * sigmoid_f(g1[3]);
#pragma unroll
                    for (int j = 0; j < 8; ++j) q += o[j] * o[j];
                    u32x4 w; w.x = cvt_pk_bf16(o[0], o[1]); w.y = cvt_pk_bf16(o[2], o[3]); w.z = cvt_pk_bf16(o[4], o[5]); w.w = cvt_pk_bf16(o[6], o[7]);
                    *(u32x4*)(MIX + (size_t)row * 4096 + col0 + bj * HALF) = w; }
                q += __shfl_xor(q, 16); q += __shfl_xor(q, 32);
                if (fq == 0) atomicAdd(SA + row, q);
            }
    }
};
struct EpiHB {
    static constexpr bool PERM = true, AFTER_DRAIN = false, MIDSCALE = true;
    bf16_t* H; const float* X; const float* RA; const float* RB; float* SH;
    __device__ __forceinline__ void midscale(f32x4 (&acc)[2][2][4][2], const Unit& u, int wr, int fr) const {
        const int row0 = u.pm * BM + wr * 64 + fr; float rt[2][4];
#pragma unroll
        for (int ai = 0; ai < 2; ++ai)
#pragma unroll
            for (int m = 0; m < 4; ++m) rt[ai][m] = RA[row0 + ai * HALF + m * 16];
#pragma unroll
        for (int ai = 0; ai < 2; ++ai)
#pragma unroll
            for (int m = 0; m < 4; ++m)
#pragma unroll
                for (int bj = 0; bj < 2; ++bj)
#pragma unroll
                    for (int n = 0; n < 2; ++n) acc[ai][bj][m][n] *= rt[ai][m];
    }
    __device__ __forceinline__ void operator()(const f32x4 (&acc)[2][2][4][2], const Unit& u, int wr, int wc, int fr, int fq) const {
        const int row0 = u.pm * BM + wr * 64 + fr, col0 = u.pn * BM + wc * 32 + 8 * fq;
#pragma unroll
        for (int ai = 0; ai < 2; ++ai)
#pragma unroll
            for (int m = 0; m < 4; ++m) { const int row = row0 + ai * HALF + m * 16; const size_t off = (size_t)row * 4096 + col0; const float rb = RB[row]; float q = 0.f;
#pragma unroll
                for (int bj = 0; bj < 2; ++bj) { const f32x4 x0 = *(const f32x4*)(X + off + bj * HALF), x1 = *(const f32x4*)(X + off + bj * HALF + 4);
                    const f32x4 v0 = acc[ai][bj][m][0] * rb + x0, v1 = acc[ai][bj][m][1] * rb + x1;
#pragma unroll
                    for (int j = 0; j < 4; ++j) q += v0[j] * v0[j] + v1[j] * v1[j];
                    u32x4 w; w.x = cvt_pk_bf16(v0[0], v0[1]); w.y = cvt_pk_bf16(v0[2], v0[3]); w.z = cvt_pk_bf16(v1[0], v1[1]); w.w = cvt_pk_bf16(v1[2], v1[3]);
                    *(u32x4*)(H + off + bj * HALF) = w; }
                q += __shfl_xor(q, 16); q += __shfl_xor(q, 32);
                if (fq == 0) atomicAdd(SH + row, q); }
    }
};
struct EpiBf16Out {
    static constexpr bool PERM = true, AFTER_DRAIN = false, MIDSCALE = false;
    bf16_t* O; int ldc; const float* SH;
    __device__ __forceinline__ void operator()(const f32x4 (&acc)[2][2][4][2], const Unit& u, int wr, int wc, int fr, int fq) const {
        const int row0 = u.pm * BM + wr * 64 + fr, col0 = u.pn * BM + wc * 32 + 8 * fq;
#pragma unroll
        for (int ai = 0; ai < 2; ++ai)
#pragma unroll
            for (int m = 0; m < 4; ++m) { const int row = row0 + ai * HALF + m * 16; bf16_t* rowp = O + (size_t)row * ldc + col0; const float rs = 1.0f / sqrtf(SH[row] * (1.0f / 4096.0f) + 1e-6f);
#pragma unroll
                for (int bj = 0; bj < 2; ++bj) { const f32x4 v0 = acc[ai][bj][m][0] * rs, v1 = acc[ai][bj][m][1] * rs;
                    u32x4 w; w.x = cvt_pk_bf16(v0[0], v0[1]); w.y = cvt_pk_bf16(v0[2], v0[3]); w.z = cvt_pk_bf16(v1[0], v1[1]); w.w = cvt_pk_bf16(v1[2], v1[3]);
                    *(u32x4*)(rowp + bj * HALF) = w; } }
    }
};
struct EpiF32Res {
    static constexpr bool PERM = false, AFTER_DRAIN = false, MIDSCALE = false;
    float* C; int ldc; const float* res;
    __device__ __forceinline__ void operator()(const f32x4 (&acc)[2][2][4][2], const Unit& u, int wr, int wc, int fr, int fq) const {
        const int row0 = u.pm * BM + wr * 64 + fr, col0 = u.pn * BM + wc * 32 + 4 * fq;
#pragma unroll
        for (int ai = 0; ai < 2; ++ai)
#pragma unroll
            for (int m = 0; m < 4; ++m) { const size_t off = (size_t)(row0 + ai * HALF + m * 16) * ldc + col0;
#pragma unroll
                for (int bj = 0; bj < 2; ++bj)
#pragma unroll
                    for (int n = 0; n < 2; ++n) { f32x4 v = acc[ai][bj][m][n]; if (res) v += *(const f32x4*)(res + off + bj * HALF + n * 16); *(f32x4*)(C + off + bj * HALF + n * 16) = v; } }
    }
};
}

constexpr int T_TOK = 16384, DM = 4096, SEQ = 4096;
constexpr int D_S5 = 2048, NZ = 6144, NZG = 4096, NG = 128;
constexpr int NEXP = 16384;
constexpr float EPS = 1e-6f;
constexpr int NWAVES = 8, NTHREADS = 512;
constexpr int LDS_BYTES = 147456;
constexpr int NPH = 10;

constexpr size_t MiB = 1u << 20;
constexpr size_t WS_CTL = 0, CTL_ZERO_BYTES = 65536;
constexpr int MISC_OFF = 147200;
constexpr size_t WS_WIN = 1 * MiB, WS_WGLU = 49 * MiB, WS_WOUT = 57 * MiB, WS_WQ = 89 * MiB;
constexpr size_t WS_DOWN = 105 * MiB, WS_UP = 153 * MiB;
constexpr size_t WS_SDN = 201 * MiB, WS_SUP = WS_SDN + 65536;
constexpr size_t WS_XQ = 202 * MiB;
constexpr size_t WS_XS = 266 * MiB, WS_XSUM = WS_XS + 65536, WS_RA = WS_XS + 131072, WS_RB = WS_XS + 196608, WS_RS = WS_XS + 262144, WS_FA = WS_XS + 327680, WS_FB = WS_XS + 393216;
#ifndef TB_D
#define TB_D 4
#endif
#ifndef TB_U
#define TB_U 4
#endif
constexpr int rowb_of(int bits) { return bits == 6 ? 3072 : bits == 5 ? 2560 : 2048; }
constexpr int ROWB_D = rowb_of(TB_D), ROWB_U = rowb_of(TB_U);
constexpr size_t WS_A1 = 361 * MiB;
constexpr size_t WS_Z = 489 * MiB;
constexpr size_t WS_HB = 617 * MiB;
constexpr size_t WS_ZS5 = 617 * MiB;
constexpr size_t WS_YS5 = 681 * MiB;
constexpr size_t WS_MIX = 745 * MiB;
constexpr size_t WS_IDX = 873 * MiB, WS_GATE = 881 * MiB;
constexpr size_t WS_STV = 889 * MiB, WS_STA = 893 * MiB, WS_STB = 895 * MiB;
constexpr size_t WS_S5T = 899 * MiB;
constexpr size_t S5T_STRIDE = 143360, S5T_K = 0, S5T_PM = 8192, S5T_QM = 8192 + 65536, S5T_A16 = 8192 + 131072;
constexpr size_t WS_S5E = 917 * MiB;
constexpr size_t WS_S5S = 981 * MiB;
constexpr size_t WS_END = 1013 * MiB;
static_assert(WS_S5T + 128 * S5T_STRIDE <= WS_S5E, "ws map");

#define GAS __attribute__((address_space(1)))
#define LAS __attribute__((address_space(3)))
typedef unsigned short bf16;
typedef unsigned v4u __attribute__((ext_vector_type(4)));
typedef unsigned v2u __attribute__((ext_vector_type(2)));
typedef float f32x4 __attribute__((ext_vector_type(4)));
typedef float f32x2 __attribute__((ext_vector_type(2)));
typedef short bf16x8 __attribute__((ext_vector_type(8)));
#define LDS_WAIT() asm volatile("s_waitcnt lgkmcnt(0)" ::: "memory")

__device__ __forceinline__ unsigned pk2(float lo, float hi) { return pg8::cvt_pk_bf16(lo, hi); }
__device__ __forceinline__ float bflo(unsigned w) { return __uint_as_float(w << 16); }
__device__ __forceinline__ float bfhi(unsigned w) { return __uint_as_float(w & 0xffff0000u); }
typedef __bf16 bf16x2_t __attribute__((ext_vector_type(2)));
__device__ __forceinline__ float dot2bf(unsigned a, unsigned b, float acc) { return __builtin_amdgcn_fdot2_f32_bf16(__builtin_bit_cast(bf16x2_t, a), __builtin_bit_cast(bf16x2_t, b), acc, false); }
__device__ __forceinline__ float wave_sum(float v) {
#pragma unroll
    for (int o = 1; o < 64; o <<= 1) v += __shfl_xor(v, o);
    return v;
}
__device__ __forceinline__ int mbcnt64(unsigned long long m) { return (int)__builtin_amdgcn_mbcnt_hi((unsigned)(m >> 32), __builtin_amdgcn_mbcnt_lo((unsigned)m, 0u)); }
__device__ __forceinline__ unsigned fkey(float f) { const unsigned u = __float_as_uint(f); return u ^ ((u >> 31) ? 0xffffffffu : 0x80000000u); }
__device__ __forceinline__ void sincos_poly(float x, float& s, float& c) {
    const float q = rintf(x * 0.63661977236758f);
    float r = fmaf(-q, 1.5703125f, x); r = fmaf(-q, 4.837512969970703125e-4f, r); r = fmaf(-q, 7.54978995489188216e-8f, r);
    const float r2 = r * r;
    float sp = fmaf(r2, 2.7557319e-6f, -1.9841270e-4f); sp = fmaf(sp, r2, 8.3333333e-3f); sp = fmaf(sp, r2, -1.6666667e-1f); sp = fmaf(sp * r2, r, r);
    float cp = fmaf(r2, -2.7557319e-7f, 2.4801587e-5f); cp = fmaf(cp, r2, -1.3888889e-3f); cp = fmaf(cp, r2, 4.1666667e-2f); cp = fmaf(cp, r2, -0.5f); cp = fmaf(cp, r2, 1.0f);
    const int n = ((int)q) & 3;
    s = (n == 0) ? sp : (n == 1) ? cp : (n == 2) ? -sp : -cp;
    c = (n == 0) ? cp : (n == 1) ? -sp : (n == 2) ? -cp : sp;
}

struct Args { const float* in[26]; float* out; unsigned char* ws; int ph_lo, ph_hi; };
#define KCONST __attribute__((address_space(4)))
template <class T> __device__ __forceinline__ T karg_ld(int off) { typedef const T KCONST* P_; return *(P_)((const KCONST char*)__builtin_amdgcn_kernarg_segment_ptr() + off); }
#define KARG(T, off) (karg_ld<T>(off))
#define AIN(i) (KARG(const float*, 8 * (i)))
#define AOUT (KARG(float*, 208))
#define AWS (KARG(unsigned char*, 216))
static_assert(sizeof(Args) == 232, "kernarg layout");
#ifndef AMP_ID
#define AMP_ID -1
#endif
#ifndef AMP_X
#define AMP_X 9
#endif
#ifndef AMP_BLK
#define AMP_BLK 0
#endif
#define AMP_ON(id) (AMP_ID == (id) && blockIdx.x == AMP_BLK && threadIdx.x == 0)
#define AMP_ACC_DECL() unsigned long long amp_acc_ = 0, amp_ts_ = 0
#define AMP_ACC_B(id) do { if (AMP_ON(id)) amp_ts_ = __builtin_amdgcn_s_memrealtime(); } while (0)
#define AMP_ACC_E(id) do { if (AMP_ON(id)) amp_acc_ += __builtin_amdgcn_s_memrealtime() - amp_ts_; } while (0)
#define AMP_ACC_SPIN(id) do { if (AMP_ON(id)) { const unsigned long long t1_ = __builtin_amdgcn_s_memrealtime(), d_ = amp_acc_ * (unsigned long long)AMP_X; while (__builtin_amdgcn_s_memrealtime() - t1_ < d_) __builtin_amdgcn_s_sleep(16); } } while (0)
#define AMP_BEGIN(id) unsigned long long amp_t0_ = 0; if (AMP_ON(id)) amp_t0_ = __builtin_amdgcn_s_memrealtime()
#define AMP_END(id) do { if (AMP_ON(id)) { const unsigned long long t1_ = __builtin_amdgcn_s_memrealtime(), d_ = (t1_ - amp_t0_) * (unsigned long long)AMP_X; while (__builtin_amdgcn_s_memrealtime() - t1_ < d_) __builtin_amdgcn_s_sleep(16); } } while (0)
enum { I_X = 0, I_GMIX, I_WIN, I_ARE, I_AIM, I_LOGDT, I_BRE, I_BIM, I_CRE, I_CIM, I_DSK, I_WGLU, I_LNG, I_LNB, I_WS, I_BS, I_GS5, I_GGM, I_WOUT, I_GFFN, I_WQ, I_K1, I_K2, I_DOWN, I_UP, I_GFIN };

constexpr int TI_1 = (4096 / 64) * (6144 / 64), TI_2 = (2048 / 64) * (2048 / 64), TI_3 = (4096 / 64) * (4096 / 64), TI_4 = (4096 / 64) * (2048 / 64), TI_ALL = TI_1 + TI_2 + TI_3 + TI_4;
struct TDesc { const float* src; bf16* dst; const float* gp; int N, K; bool hasg; };
__device__ __forceinline__ TDesc t_decode(int it) {
    const bool m1 = it < TI_1, m2 = it < TI_1 + TI_2, m3 = it < TI_1 + TI_2 + TI_3;
    const int r = m1 ? it : m2 ? it - TI_1 : m3 ? it - TI_1 - TI_2 : it - TI_1 - TI_2 - TI_3;
    TDesc d; d.K = m1 ? 4096 : m2 ? 2048 : 4096; d.N = m1 ? 6144 : m2 ? 2048 : m3 ? 4096 : 2048;
    const int nblk = d.N >> 6, kb = r / nblk, nb = r - kb * nblk, k0 = 64 * kb;
    const float* W = m1 ? AIN(I_WIN) : m2 ? AIN(I_WGLU) : m3 ? AIN(I_WOUT) : AIN(I_WQ);
    const size_t wo = m1 ? WS_WIN : m2 ? WS_WGLU : m3 ? WS_WOUT : WS_WQ;
    d.src = W + (size_t)k0 * d.N + 64 * nb; d.dst = (bf16*)(AWS + wo) + (size_t)(64 * nb) * d.K + k0;
    d.hasg = !m2 && !m1; d.gp = m3 ? ((k0 < 2048) ? AIN(I_GS5) + k0 : AIN(I_GGM) + (k0 - 2048)) : AIN(I_GFFN) + k0;
    if (!d.hasg) d.gp = W;
    return d;
}
__device__ __forceinline__ void transposes_run(LAS float* scr, int gw, int ngw, int lane) {
    const int kk = lane >> 4, n4 = lane & 15, c = lane & 7, nr = lane >> 3;
    f32x4 v[16], vn[16], sc0, sc1, sn0, sn1;
    if (gw >= TI_ALL) return;
    TDesc d = t_decode(gw);
    { const float* p = d.src + (size_t)kk * d.N + 4 * n4;
#pragma unroll
      for (int i = 0; i < 16; ++i) v[i] = *(const f32x4*)(p + (size_t)(4 * i) * d.N);
      sc0 = *(const f32x4*)(d.gp + 8 * c); sc1 = *(const f32x4*)(d.gp + 8 * c + 4); }
    for (int it = gw; it < TI_ALL; it += ngw) {
        const int itn = (it + ngw < TI_ALL) ? it + ngw : it; const TDesc dn = t_decode(itn);
        { const float* p = dn.src + (size_t)kk * dn.N + 4 * n4;
#pragma unroll
          for (int i = 0; i < 16; ++i) vn[i] = *(const f32x4*)(p + (size_t)(4 * i) * dn.N);
          sn0 = *(const f32x4*)(dn.gp + 8 * c); sn1 = *(const f32x4*)(dn.gp + 8 * c + 4); }
#pragma unroll
        for (int i = 0; i < 16; ++i) { LAS float* q = scr + (4 * i + kk) * 65 + 4 * n4; q[0] = v[i].x; q[1] = v[i].y; q[2] = v[i].z; q[3] = v[i].w; }
        LDS_WAIT(); asm volatile("" ::: "memory");
        if (!d.hasg) { sc0 = (f32x4){1.f, 1.f, 1.f, 1.f}; sc1 = sc0; }
#pragma unroll
        for (int j = 0; j < 8; ++j) { const int n = nr + 8 * j; const LAS float* s = scr + (8 * c) * 65 + n;
            v4u o; o.x = pk2(s[0 * 65] * sc0.x, s[1 * 65] * sc0.y); o.y = pk2(s[2 * 65] * sc0.z, s[3 * 65] * sc0.w); o.z = pk2(s[4 * 65] * sc1.x, s[5 * 65] * sc1.y); o.w = pk2(s[6 * 65] * sc1.z, s[7 * 65] * sc1.w);
            *(v4u*)(d.dst + (size_t)n * d.K + 8 * c) = o; }
        LDS_WAIT(); asm volatile("" ::: "memory");
#pragma unroll
        for (int i = 0; i < 16; ++i) v[i] = vn[i];
        sc0 = sn0; sc1 = sn1; d = dn;
    }
}
__device__ __forceinline__ void convert_table(const float* src, bf16* dst, size_t nchunk, size_t gtid, size_t nthr) {
#pragma unroll 4
    for (size_t i = gtid; i < nchunk; i += nthr) { const f32x4 a0 = ((const f32x4*)src)[2 * i], a1 = ((const f32x4*)src)[2 * i + 1];
        v4u o; o.x = pk2(a0.x, a0.y); o.y = pk2(a0.z, a0.w); o.z = pk2(a1.x, a1.y); o.w = pk2(a1.z, a1.w); ((v4u*)dst)[i] = o; }
}
struct __attribute__((aligned(4))) U3 { unsigned x, y, z; };
__device__ __forceinline__ float wave_max(float v) {
#pragma unroll
    for (int o = 1; o < 64; o <<= 1) v = fmaxf(v, __shfl_xor(v, o));
    return v;
}
template <int TBITS> __device__ __forceinline__ void convert_rows_i6(const float* src, unsigned char* dst, float* scl, int gw, int ngw, int lane, int rend = NEXP) {
    f32x4 v[4][4], vn[4][4];
    if (gw < rend) { const f32x4* p = (const f32x4*)(src + (size_t)gw * DM) + lane;
#pragma unroll
        for (int c = 0; c < 4; ++c)
#pragma unroll
            for (int q = 0; q < 4; ++q) v[c][q] = p[64 * (4 * c + q)]; }
    for (int r = gw; r < rend; r += ngw) {
        { const int rn = (r + ngw < rend) ? r + ngw : r; const f32x4* p = (const f32x4*)(src + (size_t)rn * DM) + lane;
#pragma unroll
          for (int c = 0; c < 4; ++c)
#pragma unroll
              for (int q = 0; q < 4; ++q) vn[c][q] = p[64 * (4 * c + q)]; }
        constexpr int ROWB = rowb_of(TBITS);
        if constexpr (TBITS == 6) {
        float mx = 0.f;
#pragma unroll
        for (int c = 0; c < 4; ++c)
#pragma unroll
            for (int q = 0; q < 4; ++q) mx = fmaxf(mx, fmaxf(fmaxf(fabsf(v[c][q].x), fabsf(v[c][q].y)), fmaxf(fabsf(v[c][q].z), fabsf(v[c][q].w))));
        mx = wave_max(mx); const float inv = mx > 0.f ? 31.0f / mx : 0.f;
        if (lane == 0) scl[r] = mx * (1.0f / 31.0f);
        unsigned pn0[4], pn1[4], ph[4];
#pragma unroll
        for (int c = 0; c < 4; ++c) { unsigned u[16];
#pragma unroll
            for (int e = 0; e < 16; ++e) u[e] = (unsigned)((int)rintf(v[c][e >> 2][e & 3] * inv) + 32);
            unsigned ox = 0u, oy = 0u, oz = 0u;
#pragma unroll
            for (int i = 0; i < 4; ++i) { ox |= ((u[2 * i] & 15u) | ((u[2 * i + 1] & 15u) << 4)) << (8 * i); oy |= ((u[8 + 2 * i] & 15u) | ((u[9 + 2 * i] & 15u) << 4)) << (8 * i);
                oz |= (((u[2 * i] >> 4) << 6) | ((u[2 * i + 1] >> 4) << 2) | ((u[8 + 2 * i] >> 4) << 4) | (u[9 + 2 * i] >> 4)) << (8 * i); }
            pn0[c] = ox; pn1[c] = oy; ph[c] = oz; }
        v4u* rp = (v4u*)(dst + (size_t)r * ROWB) + lane;
        rp[0] = (v4u){pn0[0], pn0[1], pn0[2], pn0[3]}; rp[64] = (v4u){pn1[0], pn1[1], pn1[2], pn1[3]}; rp[128] = (v4u){ph[0], ph[1], ph[2], ph[3]};
        } else {
        float ssq = 0.f;
#pragma unroll
        for (int c = 0; c < 4; ++c)
#pragma unroll
            for (int q = 0; q < 4; ++q) ssq += (v[c][q].x * v[c][q].x + v[c][q].y * v[c][q].y) + (v[c][q].z * v[c][q].z + v[c][q].w * v[c][q].w);
        const float rms = sqrtf(wave_sum(ssq) * (1.0f / DM)); constexpr float SMUL = (TBITS == 5) ? (3.0f / 15.5f) : 0.3352f; constexpr int QOFF = (TBITS == 5) ? 16 : 8, QMAX = (TBITS == 5) ? 31 : 15;
        const float step = rms > 0.f ? rms * SMUL : 1.0f, inv = 1.0f / step;
        if (lane == 0) scl[r] = step;
        unsigned pn0[4], pn1[4], hn[4];
#pragma unroll
        for (int c = 0; c < 4; ++c) { unsigned u[16];
#pragma unroll
            for (int e = 0; e < 16; ++e) { int q_ = (int)floorf(v[c][e >> 2][e & 3] * inv) + QOFF; q_ = q_ < 0 ? 0 : (q_ > QMAX ? QMAX : q_); u[e] = (unsigned)q_; }
            unsigned ox = 0u, oy = 0u, oz = 0u;
#pragma unroll
            for (int i = 0; i < 4; ++i) { ox |= ((u[2 * i] & 15u) | ((u[2 * i + 1] & 15u) << 4)) << (8 * i); oy |= ((u[8 + 2 * i] & 15u) | ((u[9 + 2 * i] & 15u) << 4)) << (8 * i);
                oz |= ((u[2 * i] >> 4) | ((u[2 * i + 1] >> 4) << 1) | ((u[8 + 2 * i] >> 4) << 2) | ((u[9 + 2 * i] >> 4) << 3)) << (4 * i); }
            pn0[c] = ox; pn1[c] = oy; hn[c] = oz; }
        unsigned h2[2];
#pragma unroll
        for (int pr = 0; pr < 2; ++pr) { unsigned w = 0u;
#pragma unroll
            for (int i = 0; i < 4; ++i) w |= (((hn[2 * pr] >> (4 * i)) & 15u) | (((hn[2 * pr + 1] >> (4 * i)) & 15u) << 4)) << (8 * i);
            h2[pr] = w; }
        unsigned char* rowp = dst + (size_t)r * ROWB;
        ((v4u*)rowp)[lane] = (v4u){pn0[0], pn0[1], pn0[2], pn0[3]}; ((v4u*)rowp)[64 + lane] = (v4u){pn1[0], pn1[1], pn1[2], pn1[3]}; if constexpr (TBITS == 5) ((v2u*)(rowp + 2048))[lane] = (v2u){h2[0], h2[1]};
        }
#pragma unroll
        for (int c = 0; c < 4; ++c)
#pragma unroll
            for (int q = 0; q < 4; ++q) v[c][q] = vn[c][q];
    }
}
__device__ __forceinline__ void norm_rows_q(const bf16* X, const float* g, unsigned char* XQ, float* XS, int* XSUM, int gw, int ngw, int lane, int rend) {
    for (int row = gw; row < rend; row += ngw) {
        const v2u* xr = (const v2u*)(X + (size_t)row * DM); f32x4 v[4][4]; float ss = 0.f;
#pragma unroll
        for (int c = 0; c < 4; ++c)
#pragma unroll
            for (int q = 0; q < 4; ++q) { const v2u w = xr[lane + 64 * (4 * c + q)]; v[c][q] = (f32x4){bflo(w.x), bfhi(w.x), bflo(w.y), bfhi(w.y)}; ss += (v[c][q].x * v[c][q].x + v[c][q].y * v[c][q].y) + (v[c][q].z * v[c][q].z + v[c][q].w * v[c][q].w); }
        const float rstd = 1.0f / sqrtf(wave_sum(ss) * (1.0f / DM) + EPS); float mx = 0.f;
#pragma unroll
        for (int c = 0; c < 4; ++c)
#pragma unroll
            for (int q = 0; q < 4; ++q) { const f32x4 gv = ((const f32x4*)g)[lane + 64 * (4 * c + q)]; v[c][q] = v[c][q] * rstd * gv;
                mx = fmaxf(mx, fmaxf(fmaxf(fabsf(v[c][q].x), fabsf(v[c][q].y)), fmaxf(fabsf(v[c][q].z), fabsf(v[c][q].w)))); }
        mx = wave_max(mx); const float inv = mx > 0.f ? 127.0f / mx : 0.f; int isum = 0;
#pragma unroll
        for (int c = 0; c < 4; ++c) { int qv[16];
#pragma unroll
            for (int e = 0; e < 16; ++e) { qv[e] = (int)rintf(v[c][e >> 2][e & 3] * inv); isum += qv[e]; }
            v4u o; o.x = 0u; o.y = 0u; o.z = 0u; o.w = 0u;
#pragma unroll
            for (int i = 0; i < 4; ++i) { o.x |= ((unsigned)qv[2 * i] & 255u) << (8 * i); o.y |= ((unsigned)qv[2 * i + 1] & 255u) << (8 * i); o.z |= ((unsigned)qv[8 + 2 * i] & 255u) << (8 * i); o.w |= ((unsigned)qv[9 + 2 * i] & 255u) << (8 * i); }
            ((v4u*)(XQ + (size_t)row * DM))[c * 64 + lane] = o;
        }
#pragma unroll
        for (int o = 1; o < 64; o <<= 1) isum += __shfl_xor(isum, o);
        if (lane == 0) { XS[row] = mx * (1.0f / 127.0f); XSUM[row] = isum; }
    }
}
__device__ __forceinline__ void norm_rows(const float* X, const float* g, bf16* O, int gw, int ngw, int lane) {
    f32x4 v[16], vn[16];
    if (gw < T_TOK) { const f32x4* xr = (const f32x4*)(X + (size_t)gw * DM) + 2 * lane;
#pragma unroll
        for (int j = 0; j < 8; ++j) { v[2 * j] = xr[128 * j]; v[2 * j + 1] = xr[128 * j + 1]; } }
    for (int row = gw; row < T_TOK; row += ngw) {
        { const int rn = (row + ngw < T_TOK) ? row + ngw : row; const f32x4* xr = (const f32x4*)(X + (size_t)rn * DM) + 2 * lane;
#pragma unroll
          for (int j = 0; j < 8; ++j) { vn[2 * j] = xr[128 * j]; vn[2 * j + 1] = xr[128 * j + 1]; } }
        float ss = 0.f;
#pragma unroll
        for (int j = 0; j < 16; ++j) ss += (v[j].x * v[j].x + v[j].y * v[j].y) + (v[j].z * v[j].z + v[j].w * v[j].w);
        const float rstd = 1.0f / sqrtf(wave_sum(ss) * (1.0f / DM) + EPS);
        v4u* o16 = (v4u*)(O + (size_t)row * DM) + lane;
#pragma unroll
        for (int j = 0; j < 8; ++j) { const f32x4 g0 = ((const f32x4*)g)[128 * j + 2 * lane], g1 = ((const f32x4*)g)[128 * j + 2 * lane + 1]; const f32x4 a0 = v[2 * j], a1 = v[2 * j + 1];
            v4u o; o.x = pk2(a0.x * rstd * g0.x, a0.y * rstd * g0.y); o.y = pk2(a0.z * rstd * g0.z, a0.w * rstd * g0.w); o.z = pk2(a1.x * rstd * g1.x, a1.y * rstd * g1.y); o.w = pk2(a1.z * rstd * g1.z, a1.w * rstd * g1.w);
            o16[64 * j] = o; }
#pragma unroll
        for (int j = 0; j < 16; ++j) v[j] = vn[j];
    }
}

__device__ __forceinline__ void s5_tables(const Args& a, LAS unsigned char* lds, int g, int part, int tid);
__device__ __forceinline__ void phase_prologue(const Args& a, LAS unsigned char* lds, int tid, int lane, int wave) {
    unsigned char* ws = AWS;
    for (int i = blockIdx.x * NTHREADS + tid; i < 3 * T_TOK; i += gridDim.x * NTHREADS) ((float*)(ws + WS_RA))[i] = 0.f;
    { AMP_BEGIN(1); for (int u = blockIdx.x; u < 2 * NG; u += gridDim.x) s5_tables(a, lds, u & (NG - 1), u >> 7, tid); AMP_END(1); }
    LAS float* scr = (LAS float*)(lds + wave * 16640);
    const int gw = blockIdx.x * NWAVES + wave, ngw = gridDim.x * NWAVES;
#define PRO_TRANSPOSES() transposes_run(scr, gw, ngw, lane)
#define PRO_TABLES() do { convert_rows_i6<TB_D>(AIN(I_DOWN), ws + WS_DOWN, (float*)(ws + WS_SDN), gw, ngw, lane); convert_rows_i6<TB_U>(AIN(I_UP), ws + WS_UP, (float*)(ws + WS_SUP), gw, ngw, lane); } while (0)
#define PRO_NORM() norm_rows(AIN(I_X), AIN(I_GMIX), (bf16*)(ws + WS_A1), gw, ngw, lane)
#ifndef TABLES_IN_TOPK
#define TABLES_IN_TOPK 1
#endif
    if (wave & 1) { PRO_NORM(); if (!TABLES_IN_TOPK) PRO_TABLES(); PRO_TRANSPOSES(); }
    else { { AMP_BEGIN(2); PRO_TRANSPOSES(); AMP_END(2); } if (!TABLES_IN_TOPK) PRO_TABLES(); { AMP_BEGIN(4); PRO_NORM(); AMP_END(4); } }
}


__device__ __forceinline__ void s5_tables(const Args& a, LAS unsigned char* lds, int g, int part, int tid) {
    LAS float* apr = (LAS float*)lds; LAS float* api = apr + 17 * 64; LAS float* bbr = api + 17 * 64; LAS float* bbi = bbr + 1024; LAS float* ccr = bbi + 1024; LAS float* cci = ccr + 1024;
    unsigned char* tb = AWS + WS_S5T + (size_t)g * S5T_STRIDE;
    for (int i = tid; i < 1024; i += NTHREADS) { ccr[i] = AIN(I_CRE)[(size_t)g * 1024 + i]; cci[i] = AIN(I_CIM)[(size_t)g * 1024 + i]; }
    if (tid < 64) { const int p = tid;
        const float lr = AIN(I_ARE)[g * 64 + p], li = AIN(I_AIM)[g * 64 + p], dt = expf(AIN(I_LOGDT)[g]);
        const float mag = expf(lr * dt); float sn, cs; sincos_poly(li * dt, sn, cs);
        const float ar = mag * cs, ai = mag * sn, nr = ar - 1.0f, ni = ai, den = lr * lr + li * li;
        const float cfr = (nr * lr + ni * li) / den, cfi = (ni * lr - nr * li) / den;
        float pr = 1.0f, pi = 0.0f;
        for (int j = 0; j <= 16; ++j) { apr[j * 64 + p] = pr; api[j * 64 + p] = pi; const float t = pr * ar - pi * ai; pi = pr * ai + pi * ar; pr = t; }
        for (int c = 0; c < 16; ++c) { const float br = AIN(I_BRE)[(size_t)(g * 64 + p) * 16 + c], bi = AIN(I_BIM)[(size_t)(g * 64 + p) * 16 + c];
            bbr[p * 16 + c] = cfr * br - cfi * bi; bbi[p * 16 + c] = cfr * bi + cfi * br; }
    }
    __syncthreads();
    if (part == 0 && tid < 64) { ((float*)(tb + S5T_A16))[tid] = apr[16 * 64 + tid]; ((float*)(tb + S5T_A16))[64 + tid] = api[16 * 64 + tid]; }
    bf16* Pm = (bf16*)(tb + S5T_PM); bf16* Qm = (bf16*)(tb + S5T_QM); bf16* Kt = (bf16*)(tb + S5T_K);
    if (part == 0) for (int idx = tid; idx < 64 * 256; idx += NTHREADS) { const int p = idx >> 8, k = idx & 255, s_ = k >> 4, cp = k & 15;
        const float ar = apr[(15 - s_) * 64 + p], ai = api[(15 - s_) * 64 + p], br = bbr[p * 16 + cp], bi = bbi[p * 16 + cp];
        Pm[p * 256 + k] = (bf16)(pk2(ar * br - ai * bi, 0.f) & 0xffffu); Pm[(64 + p) * 256 + k] = (bf16)(pk2(ar * bi + ai * br, 0.f) & 0xffffu); }
    if (part == 1) for (int idx = tid; idx < 256 * 64; idx += NTHREADS) { const int p = idx & 63, tc = idx >> 6, t = tc >> 4, c = tc & 15;
        const float cr = ccr[c * 64 + p], ci = cci[c * 64 + p], ar = apr[(t + 1) * 64 + p], ai = api[(t + 1) * 64 + p];
        Qm[tc * 128 + p] = (bf16)(pk2(cr * ar - ci * ai, 0.f) & 0xffffu); Qm[tc * 128 + 64 + p] = (bf16)(pk2(-(cr * ai + ci * ar), 0.f) & 0xffffu); }
    for (int idx = part * 2048 + tid; idx < part * 2048 + 2048; idx += NTHREADS) { const int d = idx >> 8, c = (idx >> 4) & 15, cp = idx & 15; float acc = 0.f;
#pragma unroll 8
        for (int p = 0; p < 64; ++p) { const float cr = ccr[c * 64 + p], ci = cci[c * 64 + p], ar = apr[d * 64 + p], ai = api[d * 64 + p];
            const float tr = cr * ar - ci * ai, ti = cr * ai + ci * ar; acc += tr * bbr[p * 16 + cp] - ti * bbi[p * 16 + cp]; }
        Kt[idx] = (bf16)(pk2(acc, 0.f) & 0xffffu); }
    __syncthreads();
}
constexpr int S5_PMP = 528, S5_QMP = 272, S5_LPM = 0, S5_LQM = 128 * S5_PMP, S5_LKT = S5_LQM + 256 * S5_QMP;
__device__ __forceinline__ void s5_unit(const Args& a, LAS unsigned char* lds, int g, int b0, int tid, int lane, int wave) {
    const unsigned char* tb = AWS + WS_S5T + (size_t)g * S5T_STRIDE;
    const bf16* Zg = (const bf16*)(AWS + WS_ZS5) + (size_t)g * T_TOK * 16; bf16* Y = (bf16*)(AWS + WS_YS5);
    float* Ews = (float*)(AWS + WS_S5E); bf16* Sws = (bf16*)(AWS + WS_S5S);
    AMP_ACC_DECL(); AMP_ACC_B(15);
#pragma unroll
    for (int it = 0; it < 8; ++it) { const int i = tid + NTHREADS * it;
        *(LAS v4u*)(lds + S5_LPM + (i >> 5) * S5_PMP + (i & 31) * 16) = ((const v4u*)(tb + S5T_PM))[i];
        *(LAS v4u*)(lds + S5_LQM + (i >> 4) * S5_QMP + (i & 15) * 16) = ((const v4u*)(tb + S5T_QM))[i]; }
    *(LAS v4u*)(lds + S5_LKT + tid * 16) = ((const v4u*)(tb + S5T_K))[tid];
    __syncthreads();
    AMP_ACC_E(15);
    const int fr = lane & 15, fq = lane >> 4;
#ifndef S5_NOE
    { AMP_BEGIN(11);
    for (int cb = wave; cb < 32; cb += 8) {
        const int b = b0 + (cb >> 4), chunk = (cb & 15) * 16 + fr; const size_t tok0 = (size_t)b * SEQ + chunk * 16;
        bf16x8 uf[8];
#pragma unroll
        for (int ks = 0; ks < 8; ++ks) uf[ks] = *(const bf16x8*)(Zg + (tok0 + 2 * ks + (fq >> 1)) * 16 + 8 * (fq & 1));
        float* ep = Ews + (((size_t)b * NG + g) * 256 + chunk) * 128 + 4 * fq;
#pragma unroll 2
        for (int rb = 0; rb < 8; ++rb) { f32x4 acc = (f32x4){0.f, 0.f, 0.f, 0.f};
#pragma unroll
            for (int ks = 0; ks < 8; ++ks) { const bf16x8 af = *(const LAS bf16x8*)(lds + S5_LPM + (16 * rb + fr) * S5_PMP + (32 * ks + 8 * fq) * 2); acc = __builtin_amdgcn_mfma_f32_16x16x32_bf16(af, uf[ks], acc, 0, 0, 0); }
            *(f32x4*)(ep + 16 * rb) = acc; }
    }
    AMP_END(11); }
#endif
    asm volatile("s_waitcnt vmcnt(0)" ::: "memory");
    __syncthreads();
#ifndef S5_NOR
    AMP_ACC_B(12);
    {
        const int b = b0 + (wave >> 2), seg = wave & 3, p = lane; const float a16r = ((const float*)(tb + S5T_A16))[p], a16i = ((const float*)(tb + S5T_A16))[64 + p];
        const float* Eb = Ews + (((size_t)b * NG + g) * 256 + seg * 64) * 128; bf16* Sb = Sws + (((size_t)b * NG + g) * 256 + seg * 64) * 128;
        float pr[64], pi[64]; float sr = 0.f, si = 0.f;
#pragma unroll
        for (int k0 = 0; k0 < 64; k0 += 16) { float er[16], ei[16];
#pragma unroll
            for (int j = 0; j < 16; ++j) { er[j] = Eb[(size_t)(k0 + j) * 128 + p]; ei[j] = Eb[(size_t)(k0 + j) * 128 + 64 + p]; }
#pragma unroll
            for (int j = 0; j < 16; ++j) { pr[k0 + j] = sr; pi[k0 + j] = si; const float nsr = a16r * sr - a16i * si + er[j], nsi = a16r * si + a16i * sr + ei[j]; sr = nsr; si = nsi; } }
        LAS float* xs = (LAS float*)(lds + S5_LPM);
        xs[((wave >> 2) * 4 + seg) * 128 + p] = sr; xs[((wave >> 2) * 4 + seg) * 128 + 64 + p] = si;
        float a64r = a16r, a64i = a16i;
#pragma unroll
        for (int q = 0; q < 6; ++q) { const float t = a64r * a64r - a64i * a64i; a64i = 2.0f * a64r * a64i; a64r = t; }
        __syncthreads();
        float cr = 0.f, ci = 0.f;
        for (int s2 = 0; s2 < seg; ++s2) { const float er = xs[((wave >> 2) * 4 + s2) * 128 + p], ei = xs[((wave >> 2) * 4 + s2) * 128 + 64 + p];
            const float t = a64r * cr - a64i * ci + er; ci = a64r * ci + a64i * cr + ei; cr = t; }
        float wr_ = 1.0f, wi_ = 0.0f;
#pragma unroll
        for (int j = 0; j < 64; ++j) { const float vr = pr[j] + wr_ * cr - wi_ * ci, vi = pi[j] + wr_ * ci + wi_ * cr;
            Sb[(size_t)j * 128 + p] = (bf16)(pk2(vr, 0.f) & 0xffffu); Sb[(size_t)j * 128 + 64 + p] = (bf16)(pk2(vi, 0.f) & 0xffffu);
            const float t = wr_ * a16r - wi_ * a16i; wi_ = wr_ * a16i + wi_ * a16r; wr_ = t; }
    }
#endif
    asm volatile("s_waitcnt vmcnt(0)" ::: "memory");
    __syncthreads();
    AMP_ACC_E(12);
#ifndef S5_NOY
    AMP_ACC_B(13);
    const f32x4 dsk = *(const f32x4*)(AIN(I_DSK) + g * 16 + 4 * fq);
    const int kbase = S5_LKT + fr * 32 + (fq & 1) * 16, qbase = S5_LQM + fr * S5_QMP + fq * 16, fh = fq >> 1;
    for (int cb = wave; cb < 32; cb += 8) {
        const int b = b0 + (cb >> 4), chunk = (cb & 15) * 16 + fr; const size_t tok0 = (size_t)b * SEQ + chunk * 16;
        bf16x8 uf[8], spf[4];
#pragma unroll
        for (int ks = 0; ks < 8; ++ks) uf[ks] = *(const bf16x8*)(Zg + (tok0 + 2 * ks + (fq >> 1)) * 16 + 8 * (fq & 1));
#pragma unroll
        for (int kq = 0; kq < 4; ++kq) spf[kq] = *(const bf16x8*)(Sws + (((size_t)b * NG + g) * 256 + chunk) * 128 + 32 * kq + 8 * fq);
        const bf16* zp = Zg + tok0 * 16 + 4 * fq; bf16* yp = Y + tok0 * D_S5 + g * 16 + 4 * fq;
#define S5_YBODY(t, UW) do { f32x4 acc = (f32x4){0.f, 0.f, 0.f, 0.f}; \
            _Pragma("unroll") for (int ks = 0; ks < 8; ++ks) if (2 * ks <= (t)) { const int lag = (t) - 2 * ks - fh; bf16x8 f = *(const LAS bf16x8*)(lds + kbase + (lag < 0 ? 0 : lag) * 512); \
                if (lag < 0) f = (bf16x8){0, 0, 0, 0, 0, 0, 0, 0}; acc = __builtin_amdgcn_mfma_f32_16x16x32_bf16(f, uf[ks], acc, 0, 0, 0); } \
            _Pragma("unroll") for (int kq = 0; kq < 4; ++kq) { const bf16x8 qf = *(const LAS bf16x8*)(lds + qbase + (t) * (16 * S5_QMP) + kq * 64); acc = __builtin_amdgcn_mfma_f32_16x16x32_bf16(qf, spf[kq], acc, 0, 0, 0); } \
            const float y0 = pg8::gelu_t(acc[0] + dsk[0] * bflo((UW).x)), y1 = pg8::gelu_t(acc[1] + dsk[1] * bfhi((UW).x)), y2 = pg8::gelu_t(acc[2] + dsk[2] * bflo((UW).y)), y3 = pg8::gelu_t(acc[3] + dsk[3] * bfhi((UW).y)); \
            v2u o; o.x = pk2(y0, y1); o.y = pk2(y2, y3); *(v2u*)(yp + (size_t)(t) * D_S5) = o; } while (0)
        v2u ua = *(const v2u*)zp, ub = *(const v2u*)(zp + 16);
#pragma unroll
        for (int t = 0; t < 16; t += 2) {
            S5_YBODY(t, ua); ua = *(const v2u*)(zp + (t + 2 < 16 ? t + 2 : 15) * 16);
            S5_YBODY(t + 1, ub); ub = *(const v2u*)(zp + (t + 3 < 16 ? t + 3 : 15) * 16);
        }
    }
    AMP_ACC_E(13);
#endif
    __syncthreads();
    AMP_ACC_SPIN(15); AMP_ACC_SPIN(12); AMP_ACC_SPIN(13);
}

constexpr int GM_PITCH = 272;
constexpr int GM_VT = 0, GM_WT = 256 * GM_PITCH, GM_ST = GM_WT + 128 * GM_PITCH;
__device__ __forceinline__ void gmlp_unit(const Args& a, LAS unsigned char* lds, int n, int h, bool stage_w, int tid, int lane, int wave) {
    const bf16* Z = (const bf16*)(AWS + WS_Z); bf16* MIX = (bf16*)(AWS + WS_MIX);
    const f32x2* statsV = (const f32x2*)(AWS + WS_STV); float* statsB = (float*)(AWS + WS_RB);
    const int tok0 = n * 128;
    LAS f32x2* st = (LAS f32x2*)(lds + GM_ST);
    AMP_ACC_DECL(); AMP_ACC_B(16);
    f32x2 sp8[8];
    { const f32x2* sp = statsV + (size_t)(tok0 + (tid >> 2)) * 32 + (tid & 3) * 8;
#pragma unroll
      for (int k = 0; k < 8; ++k) sp8[k] = sp[k]; }
    unsigned vw[4][8];
#pragma unroll
    for (int it = 0; it < 4; ++it) { const int item = tid + NTHREADS * it, dp = item & 127, jg = item >> 7;
#pragma unroll
        for (int r = 0; r < 8; ++r) vw[it][r] = *(const unsigned*)(Z + (size_t)(tok0 + jg * 8 + r) * NZG + 2048 + h * 256 + 2 * dp); }
    if (stage_w) {
        const int i = tid >> 2, j0 = (tid & 3) * 32; const float* wr = AIN(I_WS) + ((size_t)h * 128 + i) * 128 + j0;
#pragma unroll
        for (int q = 0; q < 4; ++q) { f32x4 x0 = ((const f32x4*)wr)[2 * q], x1 = ((const f32x4*)wr)[2 * q + 1];
            if (i < 64 && j0 + 8 * q >= 64) { x0 = (f32x4){0.f, 0.f, 0.f, 0.f}; x1 = x0; }
            v4u o; o.x = pk2(x0.x, x0.y); o.y = pk2(x0.z, x0.w); o.z = pk2(x1.x, x1.y); o.w = pk2(x1.z, x1.w);
            *(LAS v4u*)(lds + GM_WT + i * GM_PITCH + (j0 + 8 * q) * 2) = o; }
    }
    { float s = 0.f, q = 0.f;
#pragma unroll
      for (int k = 0; k < 8; ++k) { s += sp8[k].x; q += sp8[k].y; }
      s += __shfl_xor(s, 1); q += __shfl_xor(q, 1); s += __shfl_xor(s, 2); q += __shfl_xor(q, 2);
      const float mean = s * (1.0f / 2048.0f), var = q * (1.0f / 2048.0f) - mean * mean;
      if ((tid & 3) == 0) st[tid >> 2] = (f32x2){mean, 1.0f / sqrtf(var + EPS)}; }
    __syncthreads();
    AMP_ACC_E(16); AMP_ACC_B(17);
    {
#pragma unroll
        for (int it = 0; it < 4; ++it) { const int item = tid + NTHREADS * it, dp = item & 127, jg = item >> 7; const int col = h * 256 + 2 * dp;
            const float g0 = AIN(I_LNG)[col], g1 = AIN(I_LNG)[col + 1], b0 = AIN(I_LNB)[col], b1 = AIN(I_LNB)[col + 1];
            float x0[8], x1[8];
#pragma unroll
            for (int r = 0; r < 8; ++r) { const unsigned w = vw[it][r]; const f32x2 ms = st[jg * 8 + r];
                x0[r] = (bflo(w) - ms.x) * ms.y * g0 + b0; x1[r] = (bfhi(w) - ms.x) * ms.y * g1 + b1; }
            v4u o0, o1; o0.x = pk2(x0[0], x0[1]); o0.y = pk2(x0[2], x0[3]); o0.z = pk2(x0[4], x0[5]); o0.w = pk2(x0[6], x0[7]);
            o1.x = pk2(x1[0], x1[1]); o1.y = pk2(x1[2], x1[3]); o1.z = pk2(x1[4], x1[5]); o1.w = pk2(x1[6], x1[7]);
            *(LAS v4u*)(lds + GM_VT + (2 * dp) * GM_PITCH + jg * 16) = o0; *(LAS v4u*)(lds + GM_VT + (2 * dp + 1) * GM_PITCH + jg * 16) = o1; }
    }
    const int fr = lane & 15, fq = lane >> 4;
    v2u uw[8][2]; float bsv[8];
#pragma unroll
    for (int mt = 0; mt < 8; ++mt) { bsv[mt] = AIN(I_BS)[h * 128 + mt * 16 + fr];
#pragma unroll
        for (int nt = 0; nt < 2; ++nt) uw[mt][nt] = *(const v2u*)(Z + (size_t)(tok0 + mt * 16 + fr) * NZG + h * 256 + 32 * wave + 16 * nt + 4 * fq); }
    __syncthreads();
    AMP_ACC_E(17); AMP_ACC_B(18);
    bf16x8 vf[2][4];
#pragma unroll
    for (int nt = 0; nt < 2; ++nt)
#pragma unroll
        for (int ks = 0; ks < 4; ++ks) vf[nt][ks] = *(const LAS bf16x8*)(lds + GM_VT + (32 * wave + 16 * nt + fr) * GM_PITCH + (ks * 32 + 8 * fq) * 2);
#pragma unroll
    for (int mt = 0; mt < 8; ++mt) {
        bf16x8 wf[4];
#pragma unroll
        for (int ks = 0; ks < 4; ++ks) wf[ks] = *(const LAS bf16x8*)(lds + GM_WT + (mt * 16 + fr) * GM_PITCH + (ks * 32 + 8 * fq) * 2);
        f32x4 acc[2] = {(f32x4){0.f, 0.f, 0.f, 0.f}, (f32x4){0.f, 0.f, 0.f, 0.f}};
#pragma unroll
        for (int ks = 0; ks < 4; ++ks)
#pragma unroll
            for (int nt = 0; nt < 2; ++nt) acc[nt] = __builtin_amdgcn_mfma_f32_16x16x32_bf16(vf[nt][ks], wf[ks], acc[nt], 0, 0, 0);
        const size_t tok = (size_t)tok0 + mt * 16 + fr; const float bsi = bsv[mt]; float q = 0.f;
#pragma unroll
        for (int nt = 0; nt < 2; ++nt) { const int dcol = h * 256 + 32 * wave + 16 * nt + 4 * fq; const v2u u2 = uw[mt][nt];
            const float y0 = bflo(u2.x) * (acc[nt][0] + bsi), y1 = bfhi(u2.x) * (acc[nt][1] + bsi), y2 = bflo(u2.y) * (acc[nt][2] + bsi), y3 = bfhi(u2.y) * (acc[nt][3] + bsi);
            q += (y0 * y0 + y1 * y1) + (y2 * y2 + y3 * y3);
            v2u o; o.x = pk2(y0, y1); o.y = pk2(y2, y3); *(v2u*)(MIX + tok * DM + 2048 + dcol) = o; }
        q += __shfl_xor(q, 16); q += __shfl_xor(q, 32);
        if (fq == 0) atomicAdd(statsB + tok, q);
    }
    __syncthreads();
    AMP_ACC_E(18); AMP_ACC_SPIN(16); AMP_ACC_SPIN(17); AMP_ACC_SPIN(18);
}

constexpr int TK_KP = 272, TK_K2 = 128 * TK_KP, TK_SC = 2 * 128 * TK_KP, TK_SEL = TK_SC + 8 * 4096;
__device__ __forceinline__ int dpp_i(int x, const int ctrl_sel) {
    return ctrl_sel == 8 ? __builtin_amdgcn_update_dpp(0, x, 0x128, 0xf, 0xf, false) : ctrl_sel == 4 ? __builtin_amdgcn_update_dpp(0, x, 0x124, 0xf, 0xf, false)
         : ctrl_sel == 2 ? __builtin_amdgcn_update_dpp(0, x, 0x122, 0xf, 0xf, false) : __builtin_amdgcn_update_dpp(0, x, 0x121, 0xf, 0xf, false);
}
__device__ __forceinline__ int rowsum16_i(int x) { x += dpp_i(x, 8); x += dpp_i(x, 4); x += dpp_i(x, 2); x += dpp_i(x, 1); return x; }
__device__ __forceinline__ float rowsum16_f(float x) { x += __builtin_bit_cast(float, dpp_i(__builtin_bit_cast(int, x), 8)); x += __builtin_bit_cast(float, dpp_i(__builtin_bit_cast(int, x), 4));
    x += __builtin_bit_cast(float, dpp_i(__builtin_bit_cast(int, x), 2)); x += __builtin_bit_cast(float, dpp_i(__builtin_bit_cast(int, x), 1)); return x; }
__device__ __forceinline__ float rowmax16_f(float x) { x = fmaxf(x, __builtin_bit_cast(float, dpp_i(__builtin_bit_cast(int, x), 8))); x = fmaxf(x, __builtin_bit_cast(float, dpp_i(__builtin_bit_cast(int, x), 4)));
    x = fmaxf(x, __builtin_bit_cast(float, dpp_i(__builtin_bit_cast(int, x), 2))); x = fmaxf(x, __builtin_bit_cast(float, dpp_i(__builtin_bit_cast(int, x), 1))); return x; }
__device__ __forceinline__ unsigned fixkey(float s, float off, float scale) { const unsigned k = (unsigned)((s + off) * scale); return k > 0xffffu ? 0xffffu : k; }
__device__ __forceinline__ unsigned pk_sub_sat(unsigned a, unsigned b) { unsigned r; asm("v_pk_sub_u16 %0, %1, %2 clamp" : "=v"(r) : "v"(a), "v"(b)); return r; }
__device__ __forceinline__ unsigned pk_min(unsigned a, unsigned b) { unsigned r; asm("v_pk_min_u16 %0, %1, %2" : "=v"(r) : "v"(a), "v"(b)); return r; }
__device__ __forceinline__ unsigned pk_add(unsigned a, unsigned b) { unsigned r; asm("v_pk_add_u16 %0, %1, %2" : "=v"(r) : "v"(a), "v"(b)); return r; }
template <int NP> __device__ __forceinline__ unsigned group_threshold(const unsigned (&kp)[NP]) {
    unsigned T = 0u; bool done = false; unsigned ones = 0x00010001u; asm volatile("" : "+v"(ones));
    for (int bit = 15; bit >= 0; --bit) { const unsigned tr = T | (1u << bit); const unsigned tm = (tr - 1u) * 0x00010001u; unsigned c = 0u;
#pragma unroll
        for (int i = 0; i < NP; ++i) c = pk_add(c, pk_min(pk_sub_sat(kp[i], tm), ones));
        const int cnt = rowsum16_i((int)((c & 0xffffu) + (c >> 16)));
        T = (!done && cnt >= 16) ? tr : T; done = done || (cnt == 16);
        if (__ballot(!done) == 0ull) break; }
    return T;
}
constexpr int TK_WSEL = 3072;
__device__ __forceinline__ void phase_topk(const Args& a, LAS unsigned char* lds, int tid, int lane, int wave) {
    LAS float* selv = (LAS float*)(lds + TK_SC + wave * TK_WSEL); LAS int* seli = (LAS int*)(selv + 192); LAS float* fins = selv + 384; LAS int* fine = (LAS int*)(selv + 512);
    {
        const int n = tid >> 2, d0 = (tid & 3) * 32;
#pragma unroll
        for (int tb = 0; tb < 2; ++tb) { const float* kr = AIN(tb ? I_K2 : I_K1) + n * 128 + d0;
#pragma unroll
            for (int q = 0; q < 4; ++q) { const f32x4 x0 = ((const f32x4*)kr)[2 * q], x1 = ((const f32x4*)kr)[2 * q + 1];
                v4u o; o.x = pk2(x0.x, x0.y); o.y = pk2(x0.z, x0.w); o.z = pk2(x1.x, x1.y); o.w = pk2(x1.z, x1.w);
                *(LAS v4u*)(lds + tb * TK_K2 + n * TK_KP + (d0 + 8 * q) * 2) = o; } }
    }
    __syncthreads();
    const bf16* Q = (const bf16*)(AWS + WS_Z); int* IDX = (int*)(AWS + WS_IDX); float* GATE = (float*)(AWS + WS_GATE);
    const int fr = lane & 15, fq = lane >> 4; const unsigned below = (1u << fr) - 1u;
    const int gw = blockIdx.x * NWAVES + wave, ngw = gridDim.x * NWAVES; int cslice = 0;
    for (int tg = blockIdx.x; tg < T_TOK / 16; tg += gridDim.x) {
        const int tok0 = tg * 16;
        if (TABLES_IN_TOPK && cslice < 4) {
            const int q = NEXP / 4;
            if (cslice < 2) convert_rows_i6<TB_D>(AIN(I_DOWN), AWS + WS_DOWN, (float*)(AWS + WS_SDN), gw + (NEXP / 2) * cslice, ngw, lane, (NEXP / 2) * (cslice + 1));
            else convert_rows_i6<TB_U>(AIN(I_UP), AWS + WS_UP, (float*)(AWS + WS_SUP), gw + (NEXP / 2) * (cslice - 2), ngw, lane, (NEXP / 2) * (cslice - 1));
            (void)q;
            norm_rows_q((const bf16*)(AWS + WS_HB), AIN(I_GFFN), AWS + WS_XQ, (float*)(AWS + WS_XS), (int*)(AWS + WS_XSUM), gw + (T_TOK / 4) * cslice, ngw, lane, (T_TOK / 4) * (cslice + 1));
            ++cslice; }
        f32x4 acc[2][8];
#pragma unroll
        for (int hf = 0; hf < 2; ++hf)
#pragma unroll
            for (int nt = 0; nt < 8; ++nt) acc[hf][nt] = (f32x4){0.f, 0.f, 0.f, 0.f};
#pragma unroll
        for (int hf = 0; hf < 2; ++hf)
#pragma unroll
            for (int ks = 0; ks < 4; ++ks) { const bf16x8 af = *(const bf16x8*)(Q + (size_t)(tok0 + fr) * 2048 + wave * 256 + hf * 128 + 32 * ks + 8 * fq);
#pragma unroll
                for (int nt = 0; nt < 8; ++nt) { const bf16x8 kf = *(const LAS bf16x8*)(lds + hf * TK_K2 + (nt * 16 + fr) * TK_KP + (32 * ks + 8 * fq) * 2);
                    acc[hf][nt] = __builtin_amdgcn_mfma_f32_16x16x32_bf16(af, kf, acc[hf][nt], 0, 0, 0); } }
#pragma unroll
        for (int r = 0; r < 4; ++r) {
#pragma unroll
            for (int hf = 0; hf < 2; ++hf) {
                unsigned k[8], kp[4];
#pragma unroll
                for (int nt = 0; nt < 8; ++nt) k[nt] = fixkey(acc[hf][nt][r], 8.0f, 4096.0f);
#pragma unroll
                for (int i = 0; i < 4; ++i) kp[i] = k[2 * i] | (k[2 * i + 1] << 16);
                const unsigned T = group_threshold<4>(kp); int base = 0;
#pragma unroll
                for (int nt = 0; nt < 8; ++nt) { const bool sel = k[nt] >= T; const unsigned sl = (unsigned)(__ballot(sel) >> (16 * fq)) & 0xffffu; const int pos = base + __popc(sl & below);
                    const int dst = (sel && pos < 16) ? (fq * 2 + hf) * 16 + pos : 128 + lane; selv[dst] = acc[hf][nt][r]; seli[dst] = nt * 16 + fr;
                    base += __popc(sl); }
            }
            {
                const float v1 = selv[(fq * 2) * 16 + fr]; const int i1 = seli[(fq * 2) * 16 + fr]; float cv[16]; unsigned kc[16], kcp[8];
#pragma unroll
                for (int j = 0; j < 16; ++j) { cv[j] = v1 + selv[(fq * 2 + 1) * 16 + j]; kc[j] = fixkey(cv[j], 16.0f, 2048.0f); }
#pragma unroll
                for (int i = 0; i < 8; ++i) kcp[i] = kc[2 * i] | (kc[2 * i + 1] << 16);
                const unsigned T2 = group_threshold<8>(kcp); int base = 0;
#pragma unroll
                for (int j = 0; j < 16; ++j) { const bool sel = kc[j] >= T2; const unsigned sl = (unsigned)(__ballot(sel) >> (16 * fq)) & 0xffffu; const int pos = base + __popc(sl & below);
                    const int dst = (sel && pos < 16) ? fq * 16 + pos : 64 + lane; fins[dst] = cv[j]; fine[dst] = i1 * 128 + seli[(fq * 2 + 1) * 16 + j];
                    base += __popc(sl); }
            }
            {
                const float s_ = fins[fq * 16 + fr]; const float m = rowmax16_f(s_); const float e = __expf(s_ - m); const float z = rowsum16_f(e);
                const size_t t = (size_t)tok0 + 4 * fq + r;
                IDX[t * 128 + wave * 16 + fr] = fine[fq * 16 + fr]; GATE[t * 128 + wave * 16 + fr] = e / z;
            }
        }
    }
    if (TABLES_IN_TOPK) for (; cslice < 4; ++cslice) {
        norm_rows_q((const bf16*)(AWS + WS_HB), AIN(I_GFFN), AWS + WS_XQ, (float*)(AWS + WS_XS), (int*)(AWS + WS_XSUM), gw + (T_TOK / 4) * cslice, ngw, lane, (T_TOK / 4) * (cslice + 1));
        if (cslice < 2) convert_rows_i6<TB_D>(AIN(I_DOWN), AWS + WS_DOWN, (float*)(AWS + WS_SDN), gw + (NEXP / 2) * cslice, ngw, lane, (NEXP / 2) * (cslice + 1));
        else convert_rows_i6<TB_U>(AIN(I_UP), AWS + WS_UP, (float*)(AWS + WS_SUP), gw + (NEXP / 2) * (cslice - 2), ngw, lane, (NEXP / 2) * (cslice - 1)); }
}

template <int BITS> struct RowBufT { v4u n0, n1, h; };
template <> struct RowBufT<5> { v4u n0, n1; v2u h; };
template <> struct RowBufT<4> { v4u n0, n1; };
typedef RowBufT<(TB_D > TB_U ? TB_D : TB_U)> RowBuf;
template <int BITS, class RB> __device__ __forceinline__ void row_load(RB& dst, const unsigned char* rb_, int lane) {
    dst.n0 = ((const v4u*)rb_)[lane]; dst.n1 = ((const v4u*)rb_)[64 + lane];
    if constexpr (BITS == 6) dst.h = ((const v4u*)rb_)[128 + lane]; else if constexpr (BITS == 5) { const v2u h_ = ((const v2u*)(rb_ + 2048))[lane]; dst.h.x = h_.x; dst.h.y = h_.y; }
}
#define ROW_LOAD_B(BITS, dst, base, e) row_load<BITS>(dst, (base) + (size_t)(e) * rowb_of(BITS), lane)
template <int BITS, int C, class RB> __device__ __forceinline__ void row_decode(const RB& B, unsigned& g0, unsigned& g1, unsigned& g2, unsigned& g3) {
    g0 = B.n0[C] & 0x0f0f0f0fu; g1 = (B.n0[C] >> 4) & 0x0f0f0f0fu; g2 = B.n1[C] & 0x0f0f0f0fu; g3 = (B.n1[C] >> 4) & 0x0f0f0f0fu;
    if constexpr (BITS == 6) { const unsigned hw_ = B.h[C]; g0 |= (hw_ >> 2) & 0x30303030u; g1 |= (hw_ << 2) & 0x30303030u; g2 |= hw_ & 0x30303030u; g3 |= (hw_ << 4) & 0x30303030u; }
    else if constexpr (BITS == 5) { const unsigned hw_ = (C < 2) ? B.h.x : B.h.y;
        g0 |= ((C & 1) ? hw_ : (hw_ << 4)) & 0x10101010u; g1 |= ((C & 1) ? (hw_ >> 1) : (hw_ << 3)) & 0x10101010u; g2 |= ((C & 1) ? (hw_ >> 2) : (hw_ << 2)) & 0x10101010u; g3 |= ((C & 1) ? (hw_ >> 3) : (hw_ << 1)) & 0x10101010u; }
}
constexpr int toff2_of(int bits) { return bits == 6 ? 64 : bits == 5 ? 31 : 15; }
#define ROW_LOAD_SEL(dst, is_down, e) do { if (TB_D == TB_U) { const unsigned char* tb_ = (is_down) ? DOWN : UP; ROW_LOAD_B(TB_D, dst, tb_, e); } else if (is_down) ROW_LOAD_B(TB_D, dst, DOWN, e); else ROW_LOAD_B(TB_U, dst, UP, e); } while (0)
__device__ __forceinline__ void fmac_s(float& acc, float a, float b) { asm("v_fmac_f32 %0, %1, %2" : "+v"(acc) : "v"(a), "v"(b)); }
#define I6_AX(G, E0) do { fmac_s(acc[(E0)], act, (float)((G) & 255u)); fmac_s(acc[(E0) + 2], act, (float)(((G) >> 8) & 255u)); \
        fmac_s(acc[(E0) + 4], act, (float)(((G) >> 16) & 255u)); fmac_s(acc[(E0) + 6], act, (float)((G) >> 24)); } while (0)
#ifndef PG_SB
#define PG_SB __builtin_amdgcn_sched_barrier(0)
#endif
#define P1_CHUNK(B, C) do { const v4u xv_ = *(const LAS v4u*)(lds + xo_ + (C) * 1024); unsigned g0_, g1_, g2_, g3_; row_decode<TB_D, C>(B, g0_, g1_, g2_, g3_); \
            idot = __builtin_amdgcn_sdot4((int)g0_, (int)xv_.x, idot, false); idot = __builtin_amdgcn_sdot4((int)g1_, (int)xv_.y, idot, false); idot = __builtin_amdgcn_sdot4((int)g2_, (int)xv_.z, idot, false); idot = __builtin_amdgcn_sdot4((int)g3_, (int)xv_.w, idot, false); } while (0)
#define P2_CHUNK(B, C) do { unsigned g0_, g1_, g2_, g3_; row_decode<TB_U, C>(B, g0_, g1_, g2_, g3_); I6_AX(g0_, (C) * 16); I6_AX(g1_, (C) * 16 + 1); I6_AX(g2_, (C) * 16 + 8); I6_AX(g3_, (C) * 16 + 9); } while (0)
#define P1_STEP(B, J, DP) do { int idot = 0; { int xo_ = xoff; asm volatile("" : "+v"(xo_));   \
        P1_CHUNK(B, 0); P1_CHUNK(B, 1); P1_CHUNK(B, 2); P1_CHUNK(B, 3); } \
        DP = idot; \
        { const int e_ = __builtin_amdgcn_readlane(eall, (8 * k8 + 8 + (J)) & 15); ROW_LOAD_SEL(B, dn1, e_); } PG_SB; } while (0)
#define P2_STEP(B, J) do { const float act = __builtin_bit_cast(float, __builtin_amdgcn_readlane(__builtin_bit_cast(int, actv), 16 * ((J) & 3) + 4 * (2 * k8 + ((J) >> 2)))); \
        P2_CHUNK(B, 0); P2_CHUNK(B, 1); P2_CHUNK(B, 2); P2_CHUNK(B, 3); \
        { const int e_ = __builtin_amdgcn_readlane(esrc, (8 * k8 + 8 + (J)) & 15); ROW_LOAD_SEL(B, dn2, e_); } PG_SB; } while (0)
constexpr int PG_RED = 8 * 4096 * 4, PG_X = PG_RED + 64;
__device__ __forceinline__ void phase_gather(const Args& a, LAS unsigned char* lds, int tid, int lane, int wave) {
    LAS float* part = (LAS float*)lds; LAS float* red = (LAS float*)(lds + PG_RED);
    const unsigned char* XQ = AWS + WS_XQ; const unsigned char* DOWN = AWS + WS_DOWN; const unsigned char* UP = AWS + WS_UP;
    const float* SDN = (const float*)(AWS + WS_SDN); const float* SUP = (const float*)(AWS + WS_SUP); const float* XS = (const float*)(AWS + WS_XS); const int* XSUM = (const int*)(AWS + WS_XSUM);
    const int* IDX = (const int*)(AWS + WS_IDX); const float* GATE = (const float*)(AWS + WS_GATE);
    int t = blockIdx.x; if (t >= T_TOK) return;
    int eall = IDX[(size_t)t * 128 + wave * 16 + (lane & 15)]; float gall = GATE[(size_t)t * 128 + wave * 16 + (lane & 15)];
    RowBuf b0, b1, b2, b3, b4, b5, b6, b7;
    { ROW_LOAD_B(TB_D, b0, DOWN, __builtin_amdgcn_readlane(eall, 0)); ROW_LOAD_B(TB_D, b1, DOWN, __builtin_amdgcn_readlane(eall, 1)); ROW_LOAD_B(TB_D, b2, DOWN, __builtin_amdgcn_readlane(eall, 2)); ROW_LOAD_B(TB_D, b3, DOWN, __builtin_amdgcn_readlane(eall, 3));
      ROW_LOAD_B(TB_D, b4, DOWN, __builtin_amdgcn_readlane(eall, 4)); ROW_LOAD_B(TB_D, b5, DOWN, __builtin_amdgcn_readlane(eall, 5)); ROW_LOAD_B(TB_D, b6, DOWN, __builtin_amdgcn_readlane(eall, 6)); ROW_LOAD_B(TB_D, b7, DOWN, __builtin_amdgcn_readlane(eall, 7)); }
    const int xoff = PG_X + lane * 16;
    if (tid < 256) *(LAS v4u*)(lds + PG_X + tid * 16) = ((const v4u*)(XQ + (size_t)t * DM))[tid];
    __syncthreads();
    const bool h5 = lane & 32, h4 = lane & 16;
    for (; t < T_TOK; t += gridDim.x) {
        const int tn = t + gridDim.x; const size_t tq = (tn < T_TOK) ? (size_t)tn : (size_t)t;
        int lanev = lane; asm volatile("" : "+v"(lanev));
        const int eall_n = IDX[tq * 128 + wave * 16 + (lanev & 15)]; const float gall_n = GATE[tq * 128 + wave * 16 + (lanev & 15)];
        const float sdn = SDN[eall] * XS[t], sup = SUP[eall]; const int xsum = XSUM[t];
        float actv = 0.f;
#define P1_REDUCE(d0, d1, d2, d3, K4) do {   \
            const int s0_ = h5 ? d0 : d2, k0_ = h5 ? d2 : d0, s1_ = h5 ? d1 : d3, k1_ = h5 ? d3 : d1; \
            const int w0_ = k0_ + __shfl_xor(s0_, 32), w1_ = k1_ + __shfl_xor(s1_, 32); \
            int y_ = (h4 ? w1_ : w0_) + __shfl_xor(h4 ? w0_ : w1_, 16); \
            y_ += __shfl_xor(y_, 8); y_ += __shfl_xor(y_, 4); y_ += __shfl_xor(y_, 2); y_ += __shfl_xor(y_, 1); \
            const int ej_ = 4 * (K4) + (lanev >> 4); \
            const float dotv_ = (float)(2 * y_ - toff2_of(TB_D) * xsum) * 0.5f * __shfl(sdn, ej_);        \
            const float av_ = pg8::gelu_t(dotv_) * __shfl(gall, ej_) * __shfl(sup, ej_); \
            actv = (((lanev >> 2) & 3) == (K4)) ? av_ : actv; } while (0)
        static_assert(TB_D == TB_U, "the 8-buffer stream needs one row format (refills select the table by pointer, never by a branch around the loads)");
#pragma unroll 1
        for (int k8 = 0; k8 < 2; ++k8) {
            const bool dn1 = k8 < 1; int d0, d1, d2, d3, d4, d5, d6, d7;
            P1_STEP(b0, 0, d0); P1_STEP(b1, 1, d1); P1_STEP(b2, 2, d2); P1_STEP(b3, 3, d3); P1_STEP(b4, 4, d4); P1_STEP(b5, 5, d5); P1_STEP(b6, 6, d6); P1_STEP(b7, 7, d7);
            P1_REDUCE(d0, d1, d2, d3, 2 * k8); P1_REDUCE(d4, d5, d6, d7, 2 * k8 + 1);
        }
        const float amax = wave_max(fabsf(actv)); const float sa = amax * (1.0f / 127.0f), ainv = amax > 0.f ? 127.0f / amax : 0.f;
        const int aq = (int)rintf(actv * ainv);
        int aqs = aq;
#pragma unroll
        for (int o = 1; o < 64; o <<= 1) aqs += __shfl_xor(aqs, o);
        aqs >>= 2;
        int tid2 = tid; asm volatile("" : "+v"(tid2));
        const v4u xq = ((const v4u*)(XQ + tq * DM))[tid2 & 255];
        const v4u hw = *(const v4u*)((const bf16*)(AWS + WS_HB) + (size_t)t * DM + tid2 * 8);
        int iacc[64];
#pragma unroll
        for (int i = 0; i < 64; ++i) iacc[i] = 0;
#define P2_T4(G0, G1, G2, G3, E0) do {   \
            const unsigned tl01_ = __builtin_amdgcn_perm(G1, G0, 0x05010400u), th01_ = __builtin_amdgcn_perm(G1, G0, 0x07030602u), tl23_ = __builtin_amdgcn_perm(G3, G2, 0x05010400u), th23_ = __builtin_amdgcn_perm(G3, G2, 0x07030602u); \
            iacc[(E0)] = __builtin_amdgcn_sdot4((int)__builtin_amdgcn_perm(tl23_, tl01_, 0x05040100u), a4, iacc[(E0)], false); \
            iacc[(E0) + 2] = __builtin_amdgcn_sdot4((int)__builtin_amdgcn_perm(tl23_, tl01_, 0x07060302u), a4, iacc[(E0) + 2], false); \
            iacc[(E0) + 4] = __builtin_amdgcn_sdot4((int)__builtin_amdgcn_perm(th23_, th01_, 0x05040100u), a4, iacc[(E0) + 4], false); \
            iacc[(E0) + 6] = __builtin_amdgcn_sdot4((int)__builtin_amdgcn_perm(th23_, th01_, 0x07060302u), a4, iacc[(E0) + 6], false); } while (0)
#define P2_C4(BA, BB, BC, BD, C) do { unsigned ga_[4], gb_[4], gc_[4], gd_[4]; \
            row_decode<TB_U, C>(BA, ga_[0], ga_[1], ga_[2], ga_[3]); row_decode<TB_U, C>(BB, gb_[0], gb_[1], gb_[2], gb_[3]); row_decode<TB_U, C>(BC, gc_[0], gc_[1], gc_[2], gc_[3]); row_decode<TB_U, C>(BD, gd_[0], gd_[1], gd_[2], gd_[3]); \
            P2_T4(ga_[0], gb_[0], gc_[0], gd_[0], (C) * 16); P2_T4(ga_[1], gb_[1], gc_[1], gd_[1], (C) * 16 + 1); P2_T4(ga_[2], gb_[2], gc_[2], gd_[2], (C) * 16 + 8); P2_T4(ga_[3], gb_[3], gc_[3], gd_[3], (C) * 16 + 9); } while (0)
#define P2_GROUP(BA, BB, BC, BD, G4, JB) do { \
            const int a4 = (__builtin_amdgcn_readlane(aq, 4 * (G4)) & 255) | ((__builtin_amdgcn_readlane(aq, 16 + 4 * (G4)) & 255) << 8) | ((__builtin_amdgcn_readlane(aq, 32 + 4 * (G4)) & 255) << 16) | (__builtin_amdgcn_readlane(aq, 48 + 4 * (G4)) << 24); \
            P2_C4(BA, BB, BC, BD, 0); PG_SB; P2_C4(BA, BB, BC, BD, 1); PG_SB; P2_C4(BA, BB, BC, BD, 2); PG_SB; P2_C4(BA, BB, BC, BD, 3); PG_SB; \
            { const int e_ = __builtin_amdgcn_readlane(esrc, (8 * k8 + 8 + (JB)) & 15); ROW_LOAD_SEL(BA, dn2, e_); } { const int e_ = __builtin_amdgcn_readlane(esrc, (8 * k8 + 9 + (JB)) & 15); ROW_LOAD_SEL(BB, dn2, e_); } \
            { const int e_ = __builtin_amdgcn_readlane(esrc, (8 * k8 + 10 + (JB)) & 15); ROW_LOAD_SEL(BC, dn2, e_); } { const int e_ = __builtin_amdgcn_readlane(esrc, (8 * k8 + 11 + (JB)) & 15); ROW_LOAD_SEL(BD, dn2, e_); } } while (0)
#pragma unroll 1
        for (int k8 = 0; k8 < 2; ++k8) {
            const bool dn2 = !(k8 < 1); const int esrc = (k8 < 1) ? eall : eall_n;
            P2_GROUP(b0, b1, b2, b3, 2 * k8, 0); P2_GROUP(b4, b5, b6, b7, 2 * k8 + 1, 4);
        }
        const int ioff2 = toff2_of(TB_U) * aqs;
        const float sa2 = 0.5f * sa;
#pragma unroll
        for (int c = 0; c < 4; ++c) {
#pragma unroll
            for (int q = 0; q < 4; ++q) *(LAS f32x4*)(part + wave * 4096 + 4 * (lanev + 64 * (4 * c + q))) = (f32x4){(float)(2 * iacc[c * 16 + 4 * q] - ioff2) * sa2, (float)(2 * iacc[c * 16 + 4 * q + 1] - ioff2) * sa2, (float)(2 * iacc[c * 16 + 4 * q + 2] - ioff2) * sa2, (float)(2 * iacc[c * 16 + 4 * q + 3] - ioff2) * sa2}; }
        __syncthreads();
        if (tid2 < 256) *(LAS v4u*)(lds + PG_X + tid2 * 16) = xq;
        f32x4 v0 = (f32x4){bflo(hw.x), bfhi(hw.x), bflo(hw.y), bfhi(hw.y)}, v1 = (f32x4){bflo(hw.z), bfhi(hw.z), bflo(hw.w), bfhi(hw.w)};
#pragma unroll
        for (int w = 0; w < 8; ++w) { v0 += *(const LAS f32x4*)(part + w * 4096 + tid2 * 8); v1 += *(const LAS f32x4*)(part + w * 4096 + tid2 * 8 + 4); }
        float ss = (v0.x * v0.x + v0.y * v0.y) + (v0.z * v0.z + v0.w * v0.w) + (v1.x * v1.x + v1.y * v1.y) + (v1.z * v1.z + v1.w * v1.w);
        ss = wave_sum(ss);
        if (lanev == 0) red[wave] = ss;
        __syncthreads();
        float tot = 0.f;
#pragma unroll
        for (int w = 0; w < 8; ++w) tot += red[w];
        const float rstd = 1.0f / sqrtf(tot * (1.0f / DM) + EPS);
        const f32x4 g0 = *(const f32x4*)(AIN(I_GFIN) + tid2 * 8), g1 = *(const f32x4*)(AIN(I_GFIN) + tid2 * 8 + 4);
        int tid3 = tid; asm volatile("" : "+v"(tid3));
        float* orow = AOUT + (size_t)t * DM + tid3 * 8;
        *(f32x4*)orow = v0 * rstd * g0; *(f32x4*)(orow + 4) = v1 * rstd * g1;
        eall = eall_n; gall = gall_n;
    }
}

typedef GAS unsigned gu32;
#define XB_TMO      128
#define XB_XCNT(j)  (256  + 64 * (j))
#define XB_XSUB(j)  (1280 + 64 * (j))
#define XB_XGEN(j)  (2304 + 64 * (j))
#define XB_TOP      3328
#define XB_TOPGEN   3392
#define XCD_BAR_WORDS 3456
#define XB_SPIN_CAP (1u << 18)

__device__ __forceinline__ unsigned xb_ld(unsigned* p)              { return __hip_atomic_load(p, __ATOMIC_RELAXED, __HIP_MEMORY_SCOPE_AGENT); }
__device__ __forceinline__ unsigned xb_add(unsigned* p, unsigned v) { return __hip_atomic_fetch_add(p, v, __ATOMIC_RELAXED, __HIP_MEMORY_SCOPE_AGENT); }
__device__ __forceinline__ unsigned xb_xcc_id() { return (unsigned)__builtin_amdgcn_s_getreg((3 << 11) | 20) & 0xFu; }
#define XB_SPIN(cond, bar) do { unsigned _sp = 0; while (cond) { __builtin_amdgcn_s_sleep(1); \
    if ((++_sp & 255u) == 0u) { if (xb_ld(&(bar)[XB_TMO])) break; if (_sp > XB_SPIN_CAP) { atomicAdd(&(bar)[XB_TMO], 1u); break; } } } } while (0)

struct XcdBarrier {
    unsigned* bar; unsigned x;
    volatile LAS unsigned* st;
};

__device__ __forceinline__ XcdBarrier xcd_barrier_post(unsigned* bar, volatile LAS unsigned* st) {
    XcdBarrier b; b.bar = bar; b.x = xb_xcc_id(); b.st = st;
    if (threadIdx.x == 0) (void)xb_add(&bar[XB_XCNT(b.x)], 1u);
    return b;
}
__device__ __forceinline__ void xcd_barrier_complete(unsigned* bar, unsigned x, unsigned& nloc, unsigned& nx) {
    const unsigned G = gridDim.x * gridDim.y * gridDim.z;
    unsigned sum, cnt, mine, sp = 0u;
    for (;;) {
        sum = 0u; cnt = 0u; mine = 0u;
#pragma unroll
        for (unsigned j = 0; j < 16; ++j) { const unsigned c = xb_ld(&bar[XB_XCNT(j)]); sum += c; cnt += (c > 0u) ? 1u : 0u; mine = (j == x) ? c : mine; }
        if (sum == G) break;
        __builtin_amdgcn_s_sleep(1);
        if ((++sp & 255u) == 0u) { if (xb_ld(&bar[XB_TMO])) break; if (sp > XB_SPIN_CAP) { atomicAdd(&bar[XB_TMO], 1u); break; } }
    }
    nloc = mine > 0u ? mine : 1u; nx = cnt > 0u ? cnt : 1u;
}

__device__ __forceinline__ void xcd_barrier(const XcdBarrier& b) {
    asm volatile("s_waitcnt vmcnt(0)" ::: "memory");
    __syncthreads();
    if (threadIdx.x == 0) {
        unsigned* bar = b.bar;
        __builtin_amdgcn_s_waitcnt(0);
        unsigned nloc = b.st[0], nx = b.st[1];
        if (nloc == 0u) { xcd_barrier_complete(bar, b.x, nloc, nx); b.st[0] = nloc; b.st[1] = nx; }
        const unsigned old = xb_add(&bar[XB_XSUB(b.x)], 1u);
        const unsigned gen = old / nloc;
        if (old + 1u == (gen + 1u) * nloc) {
            __builtin_amdgcn_fence(__ATOMIC_RELEASE, "agent");
            asm volatile("s_waitcnt vmcnt(0)" ::: "memory");
            const unsigned og = xb_add(&bar[XB_TOP], 1u);
            const unsigned tg = og / nx;
            if (og + 1u == (tg + 1u) * nx) xb_add(&bar[XB_TOPGEN], 1u);
            else XB_SPIN(xb_ld(&bar[XB_TOPGEN]) == tg, bar);
            __builtin_amdgcn_fence(__ATOMIC_ACQUIRE, "agent");
            xb_add(&bar[XB_XGEN(b.x)], 1u);
            asm volatile("s_waitcnt vmcnt(0)" ::: "memory");
        } else {
            XB_SPIN(xb_ld(&bar[XB_XGEN(b.x)]) == gen, bar);
            __builtin_amdgcn_fence(__ATOMIC_ACQUIRE, "agent");
            asm volatile("s_waitcnt vmcnt(0)" ::: "memory");
        }
    }
    __syncthreads();
}

#ifndef PHMASK
#define PHMASK 0x3ff
#endif
#define PHE(k) ((PHMASK >> (k)) & 1)
__global__ void __launch_bounds__(NTHREADS, 2) mega(Args a) {
    extern __shared__ __attribute__((aligned(16))) unsigned char lds_raw[];
    LAS unsigned char* lds = (LAS unsigned char*)lds_raw;
    const int tid = threadIdx.x, lane = tid & 63, wave = __builtin_amdgcn_readfirstlane(tid >> 6);
    const int gw = blockIdx.x * NWAVES + wave, ngw = gridDim.x * NWAVES;
    unsigned char* ws = AWS;
    const int lo = KARG(int, 224), hi = KARG(int, 228);
    if (tid < 16) ((LAS unsigned*)(lds + MISC_OFF))[tid] = 0u;
    __syncthreads();
    XcdBarrier bar = xcd_barrier_post((unsigned*)(ws + WS_CTL), (volatile LAS unsigned*)(lds + MISC_OFF));
#define IN(k) (PHE(k) && lo <= (k) && (k) < hi)
#define SEAM(k) do { if ((k) + 1 < hi) xcd_barrier(bar); } while (0)
    if (hi > 1000) cg::this_grid().sync();
#ifndef REPMASK
#define REPMASK 0
#endif
#define REPS(k) for (int rep_ = 0; rep_ < (((REPMASK >> (k)) & 1) ? 2 : 1); ++rep_)
#define RSYNC() do { if (rep_) cg::this_grid().sync(); } while (0)
    { AMP_BEGIN(70);
    if (IN(0)) { AMP_BEGIN(50); REPS(0) { RSYNC(); phase_prologue(a, lds, tid, lane, wave); } AMP_END(50); SEAM(0); }
    AMP_END(70); }
    { AMP_BEGIN(71);
    if (IN(1)) { REPS(1) { RSYNC();
        pg8::Gemm g{(const pg8::bf16_t*)(ws + WS_A1), (const pg8::bf16_t*)(ws + WS_WIN), T_TOK, NZ, DM}; pg8::StaticOrder S; S.init(T_TOK, NZ, gridDim.x, blockIdx.x);
        pg8::EpiZ E{(pg8::bf16_t*)(ws + WS_Z), (pg8::bf16_t*)(ws + WS_ZS5), (pg8::f32x2v*)(ws + WS_STV)};
        pg8::gemm_phase<pg8::EpiZ, pg8::StaticOrder, true, true>(lds, g, S, E); }
        SEAM(1);
    }
    AMP_END(71); }
    { AMP_BEGIN(72);
    if (IN(2)) {
#define PH2_S5() do { if (gridDim.x == 256) { const int u = (blockIdx.x & 7) * 32 + (blockIdx.x >> 3);    \
              s5_unit(a, lds, u >> 1, (u & 1) * 2, tid, lane, wave); } \
            else for (int u = blockIdx.x; u < 2 * NG; u += gridDim.x) s5_unit(a, lds, u >> 1, (u & 1) * 2, tid, lane, wave); } while (0)
#define PH2_GM() do { if (gridDim.x == 256) { for (int j = 0; j < 4; ++j) gmlp_unit(a, lds, (blockIdx.x >> 3) * 4 + j, blockIdx.x & 7, j == 0, tid, lane, wave); }    \
            else for (int u = blockIdx.x; u < 1024; u += gridDim.x) gmlp_unit(a, lds, u >> 3, u & 7, true, tid, lane, wave); } while (0)
        AMP_BEGIN(62);
        { AMP_BEGIN(10); PH2_S5(); AMP_END(10); }
#if (REPMASK >> 10) & 1
        cg::this_grid().sync(); PH2_S5();
#endif
        { AMP_BEGIN(14); PH2_GM(); AMP_END(14); }
#if (REPMASK >> 11) & 1
        cg::this_grid().sync(); PH2_GM();
#endif
        SEAM(2);
        AMP_END(62);
    }
    AMP_END(72); }
    { AMP_BEGIN(73);
    if (IN(3)) { REPS(3) { RSYNC();
        pg8::Gemm g{(const pg8::bf16_t*)(ws + WS_YS5), (const pg8::bf16_t*)(ws + WS_WGLU), T_TOK, 2048, 2048}; pg8::StaticOrder S; S.init(T_TOK, 2048, gridDim.x, blockIdx.x);
        pg8::EpiGlu E{(const pg8::bf16_t*)(ws + WS_YS5), (pg8::bf16_t*)(ws + WS_MIX), (float*)(ws + WS_RA)};
        pg8::gemm_phase<pg8::EpiGlu, pg8::StaticOrder, true, true>(lds, g, S, E); }
        SEAM(3);
    }
    AMP_END(73); }
    { AMP_BEGIN(75);
    if (IN(5)) { REPS(5) { RSYNC();
        pg8::Gemm g{(const pg8::bf16_t*)(ws + WS_MIX), (const pg8::bf16_t*)(ws + WS_WOUT), T_TOK, DM, DM}; pg8::StaticOrder S; S.init(T_TOK, DM, gridDim.x, blockIdx.x);
        {
            const float* SA = (const float*)(ws + WS_RA); const float* SB = (const float*)(ws + WS_RB); float* FA = (float*)(ws + WS_FA); float* FB = (float*)(ws + WS_FB); pg8::Unit uu;
            for (int i = 0; S.next(i, uu); ++i) if (tid < 256) { const int row = uu.pm * 256 + tid; const float va = SA[row] * (1.0f / 2048.0f) + EPS, vb = SB[row] * (1.0f / 2048.0f) + EPS; FA[row] = sqrtf(vb / va); FB[row] = 1.0f / sqrtf(vb); }
            asm volatile("s_waitcnt vmcnt(0)" ::: "memory"); __syncthreads(); }
        pg8::EpiHB E{(pg8::bf16_t*)(ws + WS_HB), AIN(I_X), (const float*)(ws + WS_FA), (const float*)(ws + WS_FB), (float*)(ws + WS_RS)};
        pg8::gemm_phase<pg8::EpiHB, pg8::StaticOrder, true, true>(lds, g, S, E); }
        SEAM(5);
    }
    AMP_END(75); }
    { AMP_BEGIN(77);
    if (IN(7)) { AMP_BEGIN(57); REPS(7) { RSYNC();
        pg8::Gemm g{(const pg8::bf16_t*)(ws + WS_HB), (const pg8::bf16_t*)(ws + WS_WQ), T_TOK, 2048, DM}; pg8::StaticOrder S; S.init(T_TOK, 2048, gridDim.x, blockIdx.x);
        pg8::EpiBf16Out E{(pg8::bf16_t*)(ws + WS_Z), 2048, (const float*)(ws + WS_RS)};
        pg8::gemm_phase<pg8::EpiBf16Out, pg8::StaticOrder, true, true>(lds, g, S, E); }
        AMP_END(57);
        SEAM(7);
    }
    AMP_END(77); }
    { AMP_BEGIN(78);
    if (IN(8)) { AMP_BEGIN(58); REPS(8) { RSYNC(); phase_topk(a, lds, tid, lane, wave); } AMP_END(58); SEAM(8); }
    AMP_END(78); }
    { AMP_BEGIN(79);
    if (IN(9)) { AMP_BEGIN(59); phase_gather(a, lds, tid, lane, wave); AMP_END(59); }
    AMP_END(79); }
#undef IN
#undef SEAM
}

#ifndef ONE_LAUNCH
#define ONE_LAUNCH 1
#endif
extern "C" void kernel_launch(void* const* d_in, const int* in_sizes, int n_in, void* d_out, int out_size, void* d_ws, size_t ws_size, hipStream_t stream) {
    static int grid = 0;
    if (grid == 0) {
        if (n_in != 26 || out_size != T_TOK * DM || ws_size < WS_END) { fprintf(stderr, "kernel_launch: unexpected shapes: n_in %d out %d ws %zu\n", n_in, out_size, ws_size); grid = -1; return; }
        int dev = 0, cus = 0;
        if (hipGetDevice(&dev) != hipSuccess || hipDeviceGetAttribute(&cus, hipDeviceAttributeMultiprocessorCount, dev) != hipSuccess) { grid = -1; return; }
        if (hipFuncSetAttribute((const void*)mega, hipFuncAttributeMaxDynamicSharedMemorySize, LDS_BYTES) != hipSuccess) { fprintf(stderr, "kernel_launch: hipFuncSetAttribute failed\n"); grid = -1; return; }
        int per_cu = 0;
        if (hipOccupancyMaxActiveBlocksPerMultiprocessor(&per_cu, (const void*)mega, NTHREADS, LDS_BYTES) != hipSuccess || per_cu < 1) { fprintf(stderr, "kernel_launch: occupancy query says %d blocks per CU\n", per_cu); }
        (void)hipGetLastError();
        grid = cus;
    }
    if (grid < 0) return;
    if (hipMemsetAsync((char*)d_ws + WS_CTL, 0, CTL_ZERO_BYTES, stream) != hipSuccess) { fprintf(stderr, "kernel_launch: memset failed\n"); return; }
    Args a{};
    for (int i = 0; i < 26; ++i) a.in[i] = (const float*)d_in[i];
    a.out = (float*)d_out; a.ws = (unsigned char*)d_ws;
#if ONE_LAUNCH
    a.ph_lo = 0; a.ph_hi = NPH; void* args[] = {&a};
    hipError_t e = hipLaunchCooperativeKernel((const void*)mega, dim3(grid), dim3(NTHREADS), args, LDS_BYTES, stream);
    if (e != hipSuccess) fprintf(stderr, "cooperative launch failed: %s (grid %d)\n", hipGetErrorString(e), grid);
#else
    for (int p = 0; p < NPH; ++p) { a.ph_lo = p; a.ph_hi = p + 1; hipLaunchKernelGGL(mega, dim3(grid), dim3(NTHREADS), LDS_BYTES, stream, a); }
#endif
}
```

```cpp
#include <hip/hip_runtime.h>
#include <hip/hip_cooperative_groups.h>
#include <cstdio>
#include <cstdint>
namespace cg = cooperative_groups;
namespace pg8 {
#define PG8_LAS __attribute__((address_space(3)))
typedef unsigned short bf16_t;
typedef short bf16x8 __attribute__((ext_vector_type(8)));
typedef float f32x4 __attribute__((ext_vector_type(4)));
typedef unsigned u32x4 __attribute__((ext_vector_type(4)));
constexpr int BM = 256, BK = 64, HALF = 128, HTB = HALF * BK * 2  , STAGE_BYTES = 8 * HTB, NXCD = 8, WGM = 8;

__host__ __device__ __forceinline__ int lds_byte(int r, int c) { const int st = (r >> 4) * 2 + (c >> 5), rr = r & 15, cc = c & 31, ob = rr * 64 + cc * 2; return st * 1024 + (ob ^ (((ob >> 9) & 1) << 5)); }
__host__ __device__ __forceinline__ void stage_rc(int b, int& R, int& C) { const int st = b / 1024, sb = b % 1024, swz = sb ^ (((sb >> 9) & 1) << 5); R = (st >> 1) * 16 + swz / 64; C = (st & 1) * 32 + (swz % 64) / 2; }
__host__ __device__ __forceinline__ int perm32(int rho) { const int n = rho >> 4, i = rho & 15; return 8 * (i >> 2) + 4 * n + (i & 3); }

struct Unit { int pm, pn; };
struct Gemm { const bf16_t* A; const bf16_t* Bt; int M, N, K; };

struct StaticOrder {
    int nM, nN, nwg, G, c;
    __host__ __device__ void init(int M, int N, int G_, int c_) { nM = M / BM; nN = N / BM; nwg = nM * nN; G = G_; c = c_; }
    __host__ __device__ bool next(int i, Unit& u) const {
        const long L = (long)i * G + c; if (L >= nwg) return false;
        int wgid = (int)L; { const int q = nwg / NXCD, r = nwg % NXCD, xcd = wgid % NXCD, off = wgid / NXCD; wgid = (xcd < r ? xcd * (q + 1) : r * (q + 1) + (xcd - r) * q) + off; }
        const int nig = WGM * nN, gid = wgid / nig, fm = gid * WGM, gsz = (nM - fm) < WGM ? (nM - fm) : WGM;
        u.pm = fm + ((wgid % nig) % gsz); u.pn = (wgid % nig) / gsz; return true;
    }
    __device__ __forceinline__ void a_ready(const Unit&) const {}
    __device__ __forceinline__ void done(const Unit&) const {}
};
__device__ __forceinline__ unsigned cvt_pk_bf16(float lo, float hi) { unsigned r; asm volatile("v_cvt_pk_bf16_f32 %0, %1, %2" : "=v"(r) : "v"(lo), "v"(hi)); return r; }
template <class Epi, class Sched, bool ALIGN_EPI = false, bool SP2 = false>
__device__ __forceinline__ void gemm_phase(PG8_LAS unsigned char* lds, const Gemm g, const Sched& S, const Epi& E) {
    const int tid = threadIdx.x, wid = __builtin_amdgcn_readfirstlane(tid >> 6), lane = tid & 63, wr = wid >> 2, wc = wid & 3, fr = lane & 15, fq = lane >> 4;
    const int K = g.K, nt = K / BK;
    unsigned voffA[2], voffB[2];
#pragma unroll
    for (int i = 0; i < 2; ++i) { int R, C; stage_rc(tid * 16 + i * 8192, R, C); const int Rb = Epi::PERM ? ((R & ~31) + perm32(R & 31)) : R;
        voffA[i] = (unsigned)(R * K + C) * 2u; voffB[i] = (unsigned)(Rb * K + C) * 2u; }
    const size_t kstep = (size_t)(BK * 2);
    const size_t hstep = (size_t)HALF * K * 2;
    const size_t tstep = 2 * hstep;
    const unsigned ldsw = (unsigned)wid * 1024u;
    const int aoff = lds_byte(wr * 64 + fr, fq * 8), boff = lds_byte(wc * 32 + fr, fq * 8);
#define PG8_SA(b, h) (((b) * 2 + (h)) * HTB)
#define PG8_SB(b, h) ((4 + (b) * 2 + (h)) * HTB)
#define PG8_STAGE(bufoff, gbase, voff) do { _Pragma("unroll") for (int _i = 0; _i < 2; ++_i) \
        __builtin_amdgcn_global_load_lds((const unsigned*)((const char*)(gbase) + (voff)[_i]), (PG8_LAS unsigned*)(lds + (bufoff) + ldsw + _i * 8192), 16, 0, 0); } while (0)
#define PG8_LDA(dst, b, h) do { _Pragma("unroll") for (int m = 0; m < 4; ++m) _Pragma("unroll") for (int k = 0; k < 2; ++k) dst[m][k] = *(const PG8_LAS bf16x8*)(lds + PG8_SA(b, h) + aoff + m * 2048 + k * 1024); } while (0)
#define PG8_LDB(dst, b, h) do { _Pragma("unroll") for (int n = 0; n < 2; ++n) _Pragma("unroll") for (int k = 0; k < 2; ++k) dst[n][k] = *(const PG8_LAS bf16x8*)(lds + PG8_SB(b, h) + boff + n * 2048 + k * 1024); } while (0)
#define PG8_MMA(ai, bj, At, Bt) do { __builtin_amdgcn_s_setprio(1); _Pragma("unroll") for (int m = 0; m < 4; ++m) _Pragma("unroll") for (int n = 0; n < 2; ++n) _Pragma("unroll") for (int k = 0; k < 2; ++k) \
        acc[ai][bj][m][n] = __builtin_amdgcn_mfma_f32_16x16x32_bf16(Bt[n][k], At[m][k], acc[ai][bj][m][n], 0, 0, 0); __builtin_amdgcn_s_setprio(0); } while (0)
#define PG8_WAIT_V(n) asm volatile("s_waitcnt vmcnt(" #n ")" ::: "memory")
#define PG8_WAIT_L(n) asm volatile("s_waitcnt lgkmcnt(" #n ")" ::: "memory")
#define PG8_BAR __builtin_amdgcn_s_barrier()
#define PG8_SCHED __builtin_amdgcn_sched_barrier(0)
    Unit cur, nxt; int ui = 0;
    if (!S.next(0, cur)) return;
    f32x4 acc[2][2][4][2];
#pragma unroll
    for (int a = 0; a < 2; ++a)
#pragma unroll
        for (int b = 0; b < 2; ++b)
#pragma unroll
            for (int m = 0; m < 4; ++m)
#pragma unroll
                for (int n = 0; n < 2; ++n) acc[a][b][m][n] = (f32x4){0.f, 0.f, 0.f, 0.f};
    bf16x8 At[4][2], B0[2][2], B1[2][2];
    const char* cA = (const char*)g.A + (size_t)cur.pm * tstep; const char* cB = (const char*)g.Bt + (size_t)cur.pn * tstep;
    S.a_ready(cur);
    if constexpr (SP2) {
        PG8_STAGE(PG8_SB(0, 0), cB, voffB); PG8_STAGE(PG8_SB(0, 1), cB + hstep, voffB); PG8_STAGE(PG8_SA(0, 0), cA, voffA); PG8_STAGE(PG8_SA(0, 1), cA + hstep, voffA);
        if (wr == 1) PG8_BAR;
        PG8_WAIT_V(2); PG8_BAR;
        PG8_STAGE(PG8_SB(1, 0), cB + kstep, voffB); PG8_STAGE(PG8_SA(1, 0), cA + kstep, voffA); PG8_STAGE(PG8_SB(1, 1), cB + hstep + kstep, voffB);
        PG8_WAIT_V(6); PG8_BAR;
    } else {
        PG8_STAGE(PG8_SB(0, 0), cB, voffB); PG8_STAGE(PG8_SA(0, 0), cA, voffA); PG8_STAGE(PG8_SB(0, 1), cB + hstep, voffB); PG8_STAGE(PG8_SA(0, 1), cA + hstep, voffA);
        if (wr == 1) PG8_BAR;
        PG8_WAIT_V(4); PG8_BAR;
        PG8_STAGE(PG8_SB(1, 0), cB + kstep, voffB); PG8_STAGE(PG8_SA(1, 0), cA + kstep, voffA); PG8_STAGE(PG8_SB(1, 1), cB + hstep + kstep, voffB);
        PG8_WAIT_V(6); PG8_BAR;
    }
    for (;;) {
        const bool has_next = S.next(ui + 1, nxt);
        const char* nA = has_next ? (const char*)g.A + (size_t)nxt.pm * tstep : cA; const char* nB = has_next ? (const char*)g.Bt + (size_t)nxt.pn * tstep : cB;
        for (int t = 0; t < nt; t += 2) {
            if constexpr (Epi::MIDSCALE) { if (t == nt / 2) E.midscale(acc, cur, wr, fr, ui); }
            const bool last = (t == nt - 2);
            const char* a1 = cA + (size_t)(t + 1) * kstep;
            const char* a2 = last ? nA : cA + (size_t)(t + 2) * kstep; const char* b2 = last ? nB : cB + (size_t)(t + 2) * kstep;
            const char* a3 = a2 + kstep; const char* b3 = b2 + kstep;
            if (last && has_next) S.a_ready(nxt);
            if constexpr (SP2) {
            PG8_LDB(B0, 0, 0); PG8_LDB(B1, 0, 1); PG8_SCHED; PG8_LDA(At, 0, 0); PG8_STAGE(PG8_SA(1, 1), a1 + hstep, voffA);
            PG8_WAIT_V(8); PG8_WAIT_L(0); PG8_BAR; PG8_MMA(0, 0, At, B0); PG8_MMA(0, 1, At, B1); PG8_BAR; PG8_SCHED;
            PG8_LDA(At, 0, 1); PG8_STAGE(PG8_SB(0, 0), b2, voffB); PG8_STAGE(PG8_SB(0, 1), b2 + hstep, voffB); PG8_STAGE(PG8_SA(0, 0), a2, voffA);
            PG8_WAIT_V(8); PG8_WAIT_L(0); PG8_BAR; PG8_MMA(1, 0, At, B0); PG8_MMA(1, 1, At, B1); PG8_BAR; PG8_SCHED;
            PG8_LDB(B0, 1, 0); PG8_LDB(B1, 1, 1); PG8_SCHED; PG8_LDA(At, 1, 0); PG8_STAGE(PG8_SA(0, 1), a2 + hstep, voffA);
            PG8_WAIT_V(8); PG8_WAIT_L(0); PG8_BAR; PG8_MMA(0, 0, At, B0); PG8_MMA(0, 1, At, B1); PG8_BAR; PG8_SCHED;
            PG8_LDA(At, 1, 1); PG8_STAGE(PG8_SB(1, 0), b3, voffB); PG8_STAGE(PG8_SB(1, 1), b3 + hstep, voffB); PG8_STAGE(PG8_SA(1, 0), a3, voffA);
            PG8_WAIT_V(8); PG8_WAIT_L(0); PG8_BAR; PG8_MMA(1, 0, At, B0); PG8_MMA(1, 1, At, B1); PG8_BAR; PG8_SCHED;
            } else {
            PG8_LDB(B0, 0, 0); PG8_SCHED; PG8_LDA(At, 0, 0); PG8_STAGE(PG8_SA(1, 1), a1 + hstep, voffA);
            PG8_WAIT_L(8); PG8_BAR; PG8_WAIT_L(0); PG8_MMA(0, 0, At, B0); PG8_BAR; PG8_SCHED;
            PG8_LDB(B1, 0, 1); PG8_STAGE(PG8_SB(0, 0), b2, voffB);
            PG8_BAR; PG8_WAIT_L(0); PG8_MMA(0, 1, At, B1); PG8_BAR;
            PG8_LDA(At, 0, 1); PG8_STAGE(PG8_SA(0, 0), a2, voffA);
            PG8_BAR; PG8_WAIT_L(0); PG8_MMA(1, 0, At, B0); PG8_BAR; PG8_SCHED;
            PG8_STAGE(PG8_SB(0, 1), b2 + hstep, voffB);
            PG8_WAIT_V(6); PG8_BAR; PG8_MMA(1, 1, At, B1); PG8_BAR;
            PG8_LDB(B0, 1, 0); PG8_SCHED; PG8_LDA(At, 1, 0); PG8_STAGE(PG8_SA(0, 1), a2 + hstep, voffA);
            PG8_WAIT_L(8); PG8_BAR; PG8_WAIT_L(0); PG8_MMA(0, 0, At, B0); PG8_BAR; PG8_SCHED;
            PG8_LDB(B1, 1, 1); PG8_STAGE(PG8_SB(1, 0), b3, voffB);
            PG8_BAR; PG8_WAIT_L(0); PG8_MMA(0, 1, At, B1); PG8_BAR;
            PG8_LDA(At, 1, 1); PG8_STAGE(PG8_SA(1, 0), a3, voffA);
            PG8_BAR; PG8_WAIT_L(0); PG8_MMA(1, 0, At, B0); PG8_BAR; PG8_SCHED;
            PG8_STAGE(PG8_SB(1, 1), b3 + hstep, voffB);
            PG8_WAIT_V(6); PG8_BAR; PG8_MMA(1, 1, At, B1); PG8_BAR;
            }
        }
        if constexpr (ALIGN_EPI) { if (wr == 0) PG8_BAR; }
        if constexpr (!Epi::AFTER_DRAIN) { E(acc, cur, wr, wc, fr, fq); S.done(cur); }
        if (!has_next) break;
#pragma unroll
        for (int a = 0; a < 2; ++a)
#pragma unroll
            for (int b = 0; b < 2; ++b)
#pragma unroll
                for (int m = 0; m < 4; ++m)
#pragma unroll
                    for (int n = 0; n < 2; ++n) acc[a][b][m][n] = (f32x4){0.f, 0.f, 0.f, 0.f};
        cur = nxt; cA = nA; cB = nB; ++ui;
        if constexpr (ALIGN_EPI) { if (wr == 1) PG8_BAR; }
    }
    PG8_WAIT_V(0);
    if constexpr (!ALIGN_EPI) { if (wr == 0) PG8_BAR; }
    PG8_BAR;
    if constexpr (Epi::AFTER_DRAIN) { E.fused(acc, cur, wr, wc, fr, fq, lds, wid, lane); S.done(cur); }
#undef PG8_SA
#undef PG8_SB
#undef PG8_STAGE
#undef PG8_LDA
#undef PG8_LDB
#undef PG8_MMA
#undef PG8_WAIT_V
#undef PG8_WAIT_L
#undef PG8_BAR
#undef PG8_SCHED
}

typedef float f32x2v __attribute__((ext_vector_type(2)));
__device__ __forceinline__ float gelu_t(float x) {
    const float u = x * (1.5957691216f + 0.0713548163f * x * x);
    const float e = __builtin_amdgcn_exp2f(-1.4426950409f * u);
    return x * __builtin_amdgcn_rcpf(1.0f + e);
}
__device__ __forceinline__ float sigmoid_f(float x) { return __builtin_amdgcn_rcpf(1.0f + __builtin_amdgcn_exp2f(-1.4426950409f * x)); }
__device__ __forceinline__ float bf_lo(unsigned w) { return __uint_as_float(w << 16); }
__device__ __forceinline__ float bf_hi(unsigned w) { return __uint_as_float(w & 0xffff0000u); }

struct EpiZ {
    static constexpr bool PERM = true, AFTER_DRAIN = false, MIDSCALE = false;
    bf16_t* Z; bf16_t* ZS5; f32x2v* statsV;
    __device__ __forceinline__ void operator()(const f32x4 (&acc)[2][2][4][2], const Unit& u, int wr, int wc, int fr, int fq) const {
        const int row0 = u.pm * BM + wr * 64 + fr, col0 = u.pn * BM + wc * 32 + 8 * fq;
        const bool act = u.pn >= 8, st = u.pn >= 16;
#pragma unroll
        for (int ai = 0; ai < 2; ++ai)
#pragma unroll
            for (int m = 0; m < 4; ++m) {
                const int row = row0 + ai * HALF + m * 16; float s = 0.f, q = 0.f;
#pragma unroll
                for (int bj = 0; bj < 2; ++bj) { f32x4 v0 = acc[ai][bj][m][0], v1 = acc[ai][bj][m][1];
                    if (act) {
#pragma unroll
                        for (int j = 0; j < 4; ++j) { v0[j] = gelu_t(v0[j]); v1[j] = gelu_t(v1[j]); }
                    }
#pragma unroll
                    for (int j = 0; j < 4; ++j) { s += v0[j] + v1[j]; q += v0[j] * v0[j] + v1[j] * v1[j]; }
                    u32x4 w; w.x = cvt_pk_bf16(v0[0], v0[1]); w.y = cvt_pk_bf16(v0[2], v0[3]); w.z = cvt_pk_bf16(v1[0], v1[1]); w.w = cvt_pk_bf16(v1[2], v1[3]);
                    const int col = col0 + bj * HALF;
                    if (act) *(u32x4*)(Z + (size_t)row * 4096 + (col - 2048)) = w; else *(u32x4*)(ZS5 + ((size_t)(col >> 4) * 16384 + row) * 16 + (col & 8)) = w; }
                if (st) { s += __shfl_xor(s, 16); s += __shfl_xor(s, 32); q += __shfl_xor(q, 16); q += __shfl_xor(q, 32);
                    if (fq == 0) statsV[(size_t)row * 32 + (u.pn - 16) * 4 + wc] = (f32x2v){s, q}; }
            }
    }
};
struct EpiGlu {
    static constexpr bool PERM = true, AFTER_DRAIN = false, MIDSCALE = false;
    const bf16_t* Y; bf16_t* MIX; float* SA;
    __device__ __forceinline__ void operator()(const f32x4 (&acc)[2][2][4][2], const Unit& u, int wr, int wc, int fr, int fq) const {
        const int row0 = u.pm * BM + wr * 64 + fr, col0 = u.pn * BM + wc * 32 + 8 * fq;
#pragma unroll
        for (int ai = 0; ai < 2; ++ai)
#pragma unroll
            for (int m = 0; m < 4; ++m) {
                const int row = row0 + ai * HALF + m * 16; float q = 0.f;
#pragma unroll
                for (int bj = 0; bj < 2; ++bj) { const f32x4 g0 = acc[ai][bj][m][0], g1 = acc[ai][bj][m][1];
                    const u32x4 yw = *(const u32x4*)(Y + (size_t)row * 2048 + col0 + bj * HALF);
                    float o[8];
                    o[0] = bf_lo(yw.x) * sigmoid_f(g0[0]); o[1] = bf_hi(yw.x) * sigmoid_f(g0[1]); o[2] = bf_lo(yw.y) * sigmoid_f(g0[2]); o[3] = bf_hi(yw.y) * sigmoid_f(g0[3]);
                    o[4] = bf_lo(yw.z) * sigmoid_f(g1[0]); o[5] = bf_hi(yw.z) * sigmoid_f(g1[1]); o[6] = bf_lo(yw.w) * sigmoid_f(g1[2]); o[7] = bf_hi(yw.w) * sigmoid_f(g1[3]);
#pragma unroll
                    for (int j = 0; j < 8; ++j) q += o[j] * o[j];
                    u32x4 w; w.x = cvt_pk_bf16(o[0], o[1]); w.y = cvt_pk_bf16(o[2], o[3]); w.z = cvt_pk_bf16(o[4], o[5]); w.w = cvt_pk_bf16(o[6], o[7]);
                    *(u32x4*)(MIX + (size_t)row * 4096 + col0 + bj * HALF) = w; }
                q += __shfl_xor(q, 16); q += __shfl_xor(q, 32);
                if (fq == 0) atomicAdd(SA + row, q);
            }
    }
};
struct EpiHB {
    static constexpr bool PERM = true, AFTER_DRAIN = false, MIDSCALE = true;
    bf16_t* H; const float* X; unsigned RA_LDS; const float* RB; float* SH;
    __device__ __forceinline__ void midscale(f32x4 (&acc)[2][2][4][2], const Unit& u, int wr, int fr, int ui) const {
        const unsigned a0 = RA_LDS + (unsigned)((ui & 7) * 256 + wr * 64 + fr) * 4u; float rt[2][4];
#pragma unroll
        for (int ai = 0; ai < 2; ++ai)
#pragma unroll
            for (int m = 0; m < 4; ++m) asm volatile("ds_read_b32 %0, %1 offset:%2" : "=v"(rt[ai][m]) : "v"(a0), "n"((ai * HALF + m * 16) * 4));
        asm volatile("s_waitcnt lgkmcnt(0)" : "+v"(rt[0][0]), "+v"(rt[0][1]), "+v"(rt[0][2]), "+v"(rt[0][3]), "+v"(rt[1][0]), "+v"(rt[1][1]), "+v"(rt[1][2]), "+v"(rt[1][3]));
#pragma unroll
        for (int ai = 0; ai < 2; ++ai)
#pragma unroll
            for (int m = 0; m < 4; ++m)
#pragma unroll
                for (int bj = 0; bj < 2; ++bj)
#pragma unroll
                    for (int n = 0; n < 2; ++n) acc[ai][bj][m][n] *= rt[ai][m];
        (void)u;
    }
    __device__ __forceinline__ void operator()(const f32x4 (&acc)[2][2][4][2], const Unit& u, int wr, int wc, int fr, int fq) const {
        const int row0 = u.pm * BM + wr * 64 + fr, col0 = u.pn * BM + wc * 32 + 8 * fq;
        float rbv[8]; f32x4 xq[3][4];
#pragma unroll
        for (int i = 0; i < 8; ++i) rbv[i] = RB[row0 + (i >> 2) * HALF + (i & 3) * 16];
#define EHB_LOAD(i, slot) do { const float* xp_ = X + (size_t)(row0 + ((i) >> 2) * HALF + ((i) & 3) * 16) * 4096 + col0; \
            xq[slot][0] = __builtin_nontemporal_load((const f32x4*)xp_); xq[slot][1] = __builtin_nontemporal_load((const f32x4*)(xp_ + 4)); \
            xq[slot][2] = __builtin_nontemporal_load((const f32x4*)(xp_ + HALF)); xq[slot][3] = __builtin_nontemporal_load((const f32x4*)(xp_ + HALF + 4)); } while (0)
        EHB_LOAD(0, 0); EHB_LOAD(1, 1);
#pragma unroll
        for (int i = 0; i < 8; ++i) { const int ai = i >> 2, m = i & 3; const int row = row0 + ai * HALF + m * 16; const size_t off = (size_t)row * 4096 + col0; const float rb = rbv[i]; float q = 0.f;
            if (i + 2 < 8) EHB_LOAD(i + 2, (i + 2) % 3);
#pragma unroll
            for (int bj = 0; bj < 2; ++bj) { const f32x4 v0 = acc[ai][bj][m][0] * rb + xq[i % 3][2 * bj], v1 = acc[ai][bj][m][1] * rb + xq[i % 3][2 * bj + 1];
#pragma unroll
                for (int j = 0; j < 4; ++j) q += v0[j] * v0[j] + v1[j] * v1[j];
                u32x4 w; w.x = cvt_pk_bf16(v0[0], v0[1]); w.y = cvt_pk_bf16(v0[2], v0[3]); w.z = cvt_pk_bf16(v1[0], v1[1]); w.w = cvt_pk_bf16(v1[2], v1[3]);
                *(u32x4*)(H + off + bj * HALF) = w; }
            q += __shfl_xor(q, 16); q += __shfl_xor(q, 32);
            if (fq == 0) atomicAdd(SH + row, q); }
#undef EHB_LOAD
    }
};
struct EpiBf16Out {
    static constexpr bool PERM = true, AFTER_DRAIN = false, MIDSCALE = false;
    bf16_t* O; int ldc; const float* SH;
    __device__ __forceinline__ void operator()(const f32x4 (&acc)[2][2][4][2], const Unit& u, int wr, int wc, int fr, int fq) const {
        const int row0 = u.pm * BM + wr * 64 + fr, col0 = u.pn * BM + wc * 32 + 8 * fq;
#pragma unroll
        for (int ai = 0; ai < 2; ++ai)
#pragma unroll
            for (int m = 0; m < 4; ++m) { const int row = row0 + ai * HALF + m * 16; bf16_t* rowp = O + (size_t)row * ldc + col0; const float rs = 1.0f / sqrtf(SH[row] * (1.0f / 4096.0f) + 1e-6f);
#pragma unroll
                for (int bj = 0; bj < 2; ++bj) { const f32x4 v0 = acc[ai][bj][m][0] * rs, v1 = acc[ai][bj][m][1] * rs;
                    u32x4 w; w.x = cvt_pk_bf16(v0[0], v0[1]); w.y = cvt_pk_bf16(v0[2], v0[3]); w.z = cvt_pk_bf16(v1[0], v1[1]); w.w = cvt_pk_bf16(v1[2], v1[3]);
                    *(u32x4*)(rowp + bj * HALF) = w; } }
    }
};
struct EpiF32Res {
    static constexpr bool PERM = false, AFTER_DRAIN = false, MIDSCALE = false;
    float* C; int ldc; const float* res;
    __device__ __forceinline__ void operator()(const f32x4 (&acc)[2][2][4][2], const Unit& u, int wr, int wc, int fr, int fq) const {
        const int row0 = u.pm * BM + wr * 64 + fr, col0 = u.pn * BM + wc * 32 + 4 * fq;
#pragma unroll
        for (int ai = 0; ai < 2; ++ai)
#pragma unroll
            for (int m = 0; m < 4; ++m) { const size_t off = (size_t)(row0 + ai * HALF + m * 16) * ldc + col0;
#pragma unroll
                for (int bj = 0; bj < 2; ++bj)
#pragma unroll
                    for (int n = 0; n < 2; ++n) { f32x4 v = acc[ai][bj][m][n]; if (res) v += *(const f32x4*)(res + off + bj * HALF + n * 16); *(f32x4*)(C + off + bj * HALF + n * 16) = v; } }
    }
};
}

constexpr int T_TOK = 16384, DM = 4096, SEQ = 4096;
constexpr int D_S5 = 2048, NZ = 6144, NZG = 4096, NG = 128;
constexpr int NEXP = 16384;
constexpr float EPS = 1e-6f;
constexpr int NWAVES = 8, NTHREADS = 512;
constexpr int LDS_BYTES = 147456;
constexpr int NPH = 10;

constexpr size_t MiB = 1u << 20;
constexpr size_t WS_CTL = 0, CTL_ZERO_BYTES = 65536;
constexpr int MISC_OFF = 147200;
constexpr size_t WS_WIN = 1 * MiB, WS_WGLU = 49 * MiB, WS_WOUT = 57 * MiB, WS_WQ = 89 * MiB;
constexpr size_t WS_DOWN = 105 * MiB, WS_UP = 153 * MiB;
constexpr size_t WS_SDN = 201 * MiB, WS_SUP = WS_SDN + 65536;
constexpr size_t WS_XQ = 202 * MiB;
constexpr size_t WS_XS = 266 * MiB, WS_XSUM = WS_XS + 65536, WS_RA = WS_XS + 131072, WS_RB = WS_XS + 196608, WS_RS = WS_XS + 262144, WS_FA = WS_XS + 327680, WS_FB = WS_XS + 393216;
#ifndef TB_D
#define TB_D 4
#endif
#ifndef DOWN_SGN
#define DOWN_SGN true
#endif
#ifndef DOWN_SLICED
#define DOWN_SLICED true
#endif
#ifndef UP_SLICED
#define UP_SLICED true
#endif
#ifndef TB_U
#define TB_U 4
#endif
constexpr int rowb_of(int bits) { return bits == 6 ? 3072 : bits == 5 ? 2560 : 2048; }
constexpr int ROWB_D = rowb_of(TB_D), ROWB_U = rowb_of(TB_U);
constexpr size_t WS_A1 = 361 * MiB;
constexpr size_t WS_Z = 489 * MiB;
constexpr size_t WS_HB = 617 * MiB;
constexpr size_t WS_ZS5 = 617 * MiB;
constexpr size_t WS_YS5 = 681 * MiB;
constexpr size_t WS_MIX = 745 * MiB;
constexpr size_t WS_IDX = 873 * MiB, WS_GATE = 881 * MiB;
constexpr size_t WS_STV = 889 * MiB, WS_STA = 893 * MiB, WS_STB = 895 * MiB;
constexpr size_t WS_S5T = 899 * MiB;
constexpr size_t S5T_STRIDE = 143360, S5T_K = 0, S5T_PM = 8192, S5T_QM = 8192 + 65536, S5T_A16 = 8192 + 131072;
constexpr size_t WS_S5E = 917 * MiB;
constexpr size_t WS_S5S = 981 * MiB;
constexpr size_t WS_END = 1013 * MiB;
static_assert(WS_S5T + 128 * S5T_STRIDE <= WS_S5E, "ws map");

#define GAS __attribute__((address_space(1)))
#define LAS __attribute__((address_space(3)))
typedef unsigned short bf16;
typedef unsigned v4u __attribute__((ext_vector_type(4)));
typedef unsigned v2u __attribute__((ext_vector_type(2)));
typedef float f32x4 __attribute__((ext_vector_type(4)));
typedef float f32x2 __attribute__((ext_vector_type(2)));
typedef short bf16x8 __attribute__((ext_vector_type(8)));
#define LDS_WAIT() asm volatile("s_waitcnt lgkmcnt(0)" ::: "memory")

__device__ __forceinline__ unsigned pk2(float lo, float hi) { return pg8::cvt_pk_bf16(lo, hi); }
__device__ __forceinline__ float bflo(unsigned w) { return __uint_as_float(w << 16); }
__device__ __forceinline__ float bfhi(unsigned w) { return __uint_as_float(w & 0xffff0000u); }
typedef __bf16 bf16x2_t __attribute__((ext_vector_type(2)));
__device__ __forceinline__ float dot2bf(unsigned a, unsigned b, float acc) { return __builtin_amdgcn_fdot2_f32_bf16(__builtin_bit_cast(bf16x2_t, a), __builtin_bit_cast(bf16x2_t, b), acc, false); }
__device__ __forceinline__ float wave_sum(float v) {
#pragma unroll
    for (int o = 1; o < 64; o <<= 1) v += __shfl_xor(v, o);
    return v;
}
__device__ __forceinline__ int mbcnt64(unsigned long long m) { return (int)__builtin_amdgcn_mbcnt_hi((unsigned)(m >> 32), __builtin_amdgcn_mbcnt_lo((unsigned)m, 0u)); }
__device__ __forceinline__ unsigned fkey(float f) { const unsigned u = __float_as_uint(f); return u ^ ((u >> 31) ? 0xffffffffu : 0x80000000u); }
__device__ __forceinline__ void sincos_poly(float x, float& s, float& c) {
    const float q = rintf(x * 0.63661977236758f);
    float r = fmaf(-q, 1.5703125f, x); r = fmaf(-q, 4.837512969970703125e-4f, r); r = fmaf(-q, 7.54978995489188216e-8f, r);
    const float r2 = r * r;
    float sp = fmaf(r2, 2.7557319e-6f, -1.9841270e-4f); sp = fmaf(sp, r2, 8.3333333e-3f); sp = fmaf(sp, r2, -1.6666667e-1f); sp = fmaf(sp * r2, r, r);
    float cp = fmaf(r2, -2.7557319e-7f, 2.4801587e-5f); cp = fmaf(cp, r2, -1.3888889e-3f); cp = fmaf(cp, r2, 4.1666667e-2f); cp = fmaf(cp, r2, -0.5f); cp = fmaf(cp, r2, 1.0f);
    const int n = ((int)q) & 3;
    s = (n == 0) ? sp : (n == 1) ? cp : (n == 2) ? -sp : -cp;
    c = (n == 0) ? cp : (n == 1) ? -sp : (n == 2) ? -cp : sp;
}

struct Args { const float* in[26]; float* out; unsigned char* ws; int ph_lo, ph_hi; };
#define KCONST __attribute__((address_space(4)))
template <class T> __device__ __forceinline__ T karg_ld(int off) { typedef const T KCONST* P_; return *(P_)((const KCONST char*)__builtin_amdgcn_kernarg_segment_ptr() + off); }
#define KARG(T, off) (karg_ld<T>(off))
#define AIN(i) (KARG(const float*, 8 * (i)))
#define AOUT (KARG(float*, 208))
#define AWS (KARG(unsigned char*, 216))
static_assert(sizeof(Args) == 232, "kernarg layout");
#ifndef AMP_ID
#define AMP_ID -1
#endif
#ifndef AMP_X
#define AMP_X 9
#endif
#ifndef AMP_BLK
#define AMP_BLK 0
#endif
#define AMP_ON(id) (AMP_ID == (id) && blockIdx.x == AMP_BLK && threadIdx.x == 0)
#define AMP_ACC_DECL() unsigned long long amp_acc_ = 0, amp_ts_ = 0
#define AMP_ACC_B(id) do { if (AMP_ON(id)) amp_ts_ = __builtin_amdgcn_s_memrealtime(); } while (0)
#define AMP_ACC_E(id) do { if (AMP_ON(id)) amp_acc_ += __builtin_amdgcn_s_memrealtime() - amp_ts_; } while (0)
#define AMP_ACC_SPIN(id) do { if (AMP_ON(id)) { const unsigned long long t1_ = __builtin_amdgcn_s_memrealtime(), d_ = amp_acc_ * (unsigned long long)AMP_X; while (__builtin_amdgcn_s_memrealtime() - t1_ < d_) __builtin_amdgcn_s_sleep(16); } } while (0)
#define AMP_BEGIN(id) unsigned long long amp_t0_ = 0; if (AMP_ON(id)) amp_t0_ = __builtin_amdgcn_s_memrealtime()
#define AMP_END(id) do { if (AMP_ON(id)) { const unsigned long long t1_ = __builtin_amdgcn_s_memrealtime(), d_ = (t1_ - amp_t0_) * (unsigned long long)AMP_X; while (__builtin_amdgcn_s_memrealtime() - t1_ < d_) __builtin_amdgcn_s_sleep(16); } } while (0)
enum { I_X = 0, I_GMIX, I_WIN, I_ARE, I_AIM, I_LOGDT, I_BRE, I_BIM, I_CRE, I_CIM, I_DSK, I_WGLU, I_LNG, I_LNB, I_WS, I_BS, I_GS5, I_GGM, I_WOUT, I_GFFN, I_WQ, I_K1, I_K2, I_DOWN, I_UP, I_GFIN };

constexpr int TI_1 = (4096 / 64) * (6144 / 64), TI_2 = (2048 / 64) * (2048 / 64), TI_3 = (4096 / 64) * (4096 / 64), TI_4 = (4096 / 64) * (2048 / 64), TI_ALL = TI_1 + TI_2 + TI_3 + TI_4;
struct TDesc { const float* src; bf16* dst; const float* gp; int N, K; bool hasg; };
__device__ __forceinline__ TDesc t_decode(int it) {
    const bool m1 = it < TI_1, m2 = it < TI_1 + TI_2, m3 = it < TI_1 + TI_2 + TI_3;
    const int r = m1 ? it : m2 ? it - TI_1 : m3 ? it - TI_1 - TI_2 : it - TI_1 - TI_2 - TI_3;
    TDesc d; d.K = m1 ? 4096 : m2 ? 2048 : 4096; d.N = m1 ? 6144 : m2 ? 2048 : m3 ? 4096 : 2048;
    const int nblk = d.N >> 6, kb = r / nblk, nb = r - kb * nblk, k0 = 64 * kb;
    const float* W = m1 ? AIN(I_WIN) : m2 ? AIN(I_WGLU) : m3 ? AIN(I_WOUT) : AIN(I_WQ);
    const size_t wo = m1 ? WS_WIN : m2 ? WS_WGLU : m3 ? WS_WOUT : WS_WQ;
    d.src = W + (size_t)k0 * d.N + 64 * nb; d.dst = (bf16*)(AWS + wo) + (size_t)(64 * nb) * d.K + k0;
    d.hasg = !m2 && !m1; d.gp = m3 ? ((k0 < 2048) ? AIN(I_GS5) + k0 : AIN(I_GGM) + (k0 - 2048)) : AIN(I_GFFN) + k0;
    if (!d.hasg) d.gp = W;
    return d;
}
__device__ __forceinline__ void transposes_run(LAS float* scr, int gw, int ngw, int lane) {
    const int kk = lane >> 4, n4 = lane & 15, c = lane & 7, nr = lane >> 3;
    f32x4 v[16], vn[16], sc0, sc1, sn0, sn1;
    if (gw >= TI_ALL) return;
    TDesc d = t_decode(gw);
    { const float* p = d.src + (size_t)kk * d.N + 4 * n4;
#pragma unroll
      for (int i = 0; i < 16; ++i) v[i] = __builtin_nontemporal_load((const f32x4*)(p + (size_t)(4 * i) * d.N));
      sc0 = *(const f32x4*)(d.gp + 8 * c); sc1 = *(const f32x4*)(d.gp + 8 * c + 4); }
    for (int it = gw; it < TI_ALL; it += ngw) {
        const int itn = (it + ngw < TI_ALL) ? it + ngw : it; const TDesc dn = t_decode(itn);
        { const float* p = dn.src + (size_t)kk * dn.N + 4 * n4;
#pragma unroll
          for (int i = 0; i < 16; ++i) vn[i] = __builtin_nontemporal_load((const f32x4*)(p + (size_t)(4 * i) * dn.N));
          sn0 = *(const f32x4*)(dn.gp + 8 * c); sn1 = *(const f32x4*)(dn.gp + 8 * c + 4); }
#pragma unroll
        for (int i = 0; i < 16; ++i) { LAS float* q = scr + (4 * i + kk) * 65 + 4 * n4; q[0] = v[i].x; q[1] = v[i].y; q[2] = v[i].z; q[3] = v[i].w; }
        LDS_WAIT(); asm volatile("" ::: "memory");
        if (!d.hasg) { sc0 = (f32x4){1.f, 1.f, 1.f, 1.f}; sc1 = sc0; }
#pragma unroll
        for (int j = 0; j < 8; ++j) { const int n = nr + 8 * j; const LAS float* s = scr + (8 * c) * 65 + n;
            v4u o; o.x = pk2(s[0 * 65] * sc0.x, s[1 * 65] * sc0.y); o.y = pk2(s[2 * 65] * sc0.z, s[3 * 65] * sc0.w); o.z = pk2(s[4 * 65] * sc1.x, s[5 * 65] * sc1.y); o.w = pk2(s[6 * 65] * sc1.z, s[7 * 65] * sc1.w);
            *(v4u*)(d.dst + (size_t)n * d.K + 8 * c) = o; }
        LDS_WAIT(); asm volatile("" ::: "memory");
#pragma unroll
        for (int i = 0; i < 16; ++i) v[i] = vn[i];
        sc0 = sn0; sc1 = sn1; d = dn;
    }
}
__device__ __forceinline__ void convert_table(const float* src, bf16* dst, size_t nchunk, size_t gtid, size_t nthr) {
#pragma unroll 4
    for (size_t i = gtid; i < nchunk; i += nthr) { const f32x4 a0 = ((const f32x4*)src)[2 * i], a1 = ((const f32x4*)src)[2 * i + 1];
        v4u o; o.x = pk2(a0.x, a0.y); o.y = pk2(a0.z, a0.w); o.z = pk2(a1.x, a1.y); o.w = pk2(a1.z, a1.w); ((v4u*)dst)[i] = o; }
}
struct __attribute__((aligned(4))) U3 { unsigned x, y, z; };
__device__ __forceinline__ float wave_max(float v) {
#pragma unroll
    for (int o = 1; o < 64; o <<= 1) v = fmaxf(v, __shfl_xor(v, o));
    return v;
}
template <int TBITS, bool SGN = false, bool SLICED = false> __device__ __forceinline__ void convert_rows_i6(const float* src, unsigned char* dst, float* scl, int gw, int ngw, int lane, int rend = NEXP) {
    f32x4 v[4][4], vn[4][4];
    if (gw < rend) { const f32x4* p = (const f32x4*)(src + (size_t)gw * DM) + lane;
#pragma unroll
        for (int c = 0; c < 4; ++c)
#pragma unroll
            for (int q = 0; q < 4; ++q) v[c][q] = __builtin_nontemporal_load(p + 64 * (4 * c + q)); }
    for (int r = gw; r < rend; r += ngw) {
        { const int rn = (r + ngw < rend) ? r + ngw : r; const f32x4* p = (const f32x4*)(src + (size_t)rn * DM) + lane;
#pragma unroll
          for (int c = 0; c < 4; ++c)
#pragma unroll
              for (int q = 0; q < 4; ++q) vn[c][q] = __builtin_nontemporal_load(p + 64 * (4 * c + q)); }
        constexpr int ROWB = rowb_of(TBITS);
        if constexpr (TBITS == 6) {
        float mx = 0.f;
#pragma unroll
        for (int c = 0; c < 4; ++c)
#pragma unroll
            for (int q = 0; q < 4; ++q) mx = fmaxf(mx, fmaxf(fmaxf(fabsf(v[c][q].x), fabsf(v[c][q].y)), fmaxf(fabsf(v[c][q].z), fabsf(v[c][q].w))));
        mx = wave_max(mx); const float inv = mx > 0.f ? 31.0f / mx : 0.f;
        if (lane == 0) scl[r] = mx * (1.0f / 31.0f);
        unsigned pn0[4], pn1[4], ph[4];
#pragma unroll
        for (int c = 0; c < 4; ++c) { unsigned u[16];
#pragma unroll
            for (int e = 0; e < 16; ++e) u[e] = (unsigned)((int)rintf(v[c][e >> 2][e & 3] * inv) + 32);
            unsigned ox = 0u, oy = 0u, oz = 0u;
#pragma unroll
            for (int i = 0; i < 4; ++i) { ox |= ((u[2 * i] & 15u) | ((u[2 * i + 1] & 15u) << 4)) << (8 * i); oy |= ((u[8 + 2 * i] & 15u) | ((u[9 + 2 * i] & 15u) << 4)) << (8 * i);
                oz |= (((u[2 * i] >> 4) << 6) | ((u[2 * i + 1] >> 4) << 2) | ((u[8 + 2 * i] >> 4) << 4) | (u[9 + 2 * i] >> 4)) << (8 * i); }
            pn0[c] = ox; pn1[c] = oy; ph[c] = oz; }
        v4u* rp = (v4u*)(dst + (size_t)r * ROWB) + lane;
        rp[0] = (v4u){pn0[0], pn0[1], pn0[2], pn0[3]}; rp[64] = (v4u){pn1[0], pn1[1], pn1[2], pn1[3]}; rp[128] = (v4u){ph[0], ph[1], ph[2], ph[3]};
        } else {
        float ssq = 0.f;
#pragma unroll
        for (int c = 0; c < 4; ++c)
#pragma unroll
            for (int q = 0; q < 4; ++q) ssq += (v[c][q].x * v[c][q].x + v[c][q].y * v[c][q].y) + (v[c][q].z * v[c][q].z + v[c][q].w * v[c][q].w);
        const float rms = sqrtf(wave_sum(ssq) * (1.0f / DM)); constexpr float SMUL = (TBITS == 5) ? (3.0f / 15.5f) : 0.3352f; constexpr int QOFF = (TBITS == 5) ? 16 : 8, QMAX = (TBITS == 5) ? 31 : 15;
        const float step = rms > 0.f ? rms * SMUL : 1.0f, inv = 1.0f / step;
        if (lane == 0) scl[r] = step;
        unsigned pn0[4], pn1[4], hn[4];
#pragma unroll
        for (int c = 0; c < 4; ++c) { unsigned u[16];
#pragma unroll
            for (int e = 0; e < 16; ++e) { const unsigned q_ = (unsigned)fmaxf(fmaf(v[c][e >> 2][e & 3], inv, (float)QOFF), 0.0f); u[e] = q_ > (unsigned)QMAX ? (unsigned)QMAX : q_; }
            unsigned ox = 0u, oy = 0u, oz = 0u;
#pragma unroll
            for (int i = 0; i < 4; ++i) {
                if constexpr (TBITS == 4) { ox |= u[2 * i] << (8 * i); ox |= u[2 * i + 1] << (8 * i + 4); oy |= u[8 + 2 * i] << (8 * i); oy |= u[9 + 2 * i] << (8 * i + 4); }
                else { ox |= ((u[2 * i] & 15u) | ((u[2 * i + 1] & 15u) << 4)) << (8 * i); oy |= ((u[8 + 2 * i] & 15u) | ((u[9 + 2 * i] & 15u) << 4)) << (8 * i);
                    oz |= ((u[2 * i] >> 4) | ((u[2 * i + 1] >> 4) << 1) | ((u[8 + 2 * i] >> 4) << 2) | ((u[9 + 2 * i] >> 4) << 3)) << (4 * i); } }
            if constexpr (SGN) { ox ^= 0x88888888u; oy ^= 0x88888888u; }
            pn0[c] = ox; pn1[c] = oy; hn[c] = oz; }
        unsigned h2[2];
#pragma unroll
        for (int pr = 0; pr < 2; ++pr) { unsigned w = 0u;
#pragma unroll
            for (int i = 0; i < 4; ++i) w |= (((hn[2 * pr] >> (4 * i)) & 15u) | (((hn[2 * pr + 1] >> (4 * i)) & 15u) << 4)) << (8 * i);
            h2[pr] = w; }
        unsigned char* rowp = dst + (size_t)r * ROWB;
        if constexpr (SLICED) {
#pragma unroll
            for (int c = 0; c < 4; ++c) if (!SGN) { pn0[c] ^= 0x80808080u; pn1[c] ^= 0x80808080u; }
#pragma unroll
            for (int c = 0; c < 4; ++c) { ((unsigned*)(dst + ((size_t)(2 * c) * NEXP + r) * 256))[lane] = pn0[c]; ((unsigned*)(dst + ((size_t)(2 * c + 1) * NEXP + r) * 256))[lane] = pn1[c]; }
            (void)rowp; } else {
        ((v4u*)rowp)[lane] = (v4u){pn0[0], pn0[1], pn0[2], pn0[3]}; ((v4u*)rowp)[64 + lane] = (v4u){pn1[0], pn1[1], pn1[2], pn1[3]}; if constexpr (TBITS == 5) ((v2u*)(rowp + 2048))[lane] = (v2u){h2[0], h2[1]}; }
        }
#pragma unroll
        for (int c = 0; c < 4; ++c)
#pragma unroll
            for (int q = 0; q < 4; ++q) v[c][q] = vn[c][q];
    }
}
__device__ __forceinline__ void norm_rows_q(const bf16* X, const float* g, unsigned char* XQ, float* XS, int* XSUM, int gw, int ngw, int lane, int rend) {
    for (int row = gw; row < rend; row += ngw) {
        const v2u* xr = (const v2u*)(X + (size_t)row * DM); f32x4 v[4][4]; float ss = 0.f;
#pragma unroll
        for (int c = 0; c < 4; ++c)
#pragma unroll
            for (int q = 0; q < 4; ++q) { const v2u w = xr[lane + 64 * (4 * c + q)]; v[c][q] = (f32x4){bflo(w.x), bfhi(w.x), bflo(w.y), bfhi(w.y)}; ss += (v[c][q].x * v[c][q].x + v[c][q].y * v[c][q].y) + (v[c][q].z * v[c][q].z + v[c][q].w * v[c][q].w); }
        const float rstd = 1.0f / sqrtf(wave_sum(ss) * (1.0f / DM) + EPS); float mx = 0.f;
#pragma unroll
        for (int c = 0; c < 4; ++c)
#pragma unroll
            for (int q = 0; q < 4; ++q) { const f32x4 gv = ((const f32x4*)g)[lane + 64 * (4 * c + q)]; v[c][q] = v[c][q] * gv;
                mx = fmaxf(mx, fmaxf(fmaxf(fabsf(v[c][q].x), fabsf(v[c][q].y)), fmaxf(fabsf(v[c][q].z), fabsf(v[c][q].w)))); }
        mx = wave_max(mx) * rstd; const float QMX = DOWN_SGN ? 119.0f : 127.0f; const float inv = mx > 0.f ? QMX / mx : 0.f, qs = rstd * inv; int isum = 0;
#pragma unroll
        for (int c = 0; c < 4; ++c) { unsigned f[16];
#pragma unroll
            for (int e = 0; e < 16; ++e) f[e] = __float_as_uint(fmaf(v[c][e >> 2][e & 3], qs, DOWN_SGN ? 12582920.0f : 12582912.0f));
            v4u o;
#define NQ_PK4(a0, a1, a2, a3) __builtin_amdgcn_perm(f[a3], __builtin_amdgcn_perm(f[a2], __builtin_amdgcn_perm(f[a1], f[a0], 0x0c0c0400u), 0x0c040100u), 0x04020100u)
            o.x = NQ_PK4(0, 2, 4, 6); o.y = NQ_PK4(1, 3, 5, 7); o.z = NQ_PK4(8, 10, 12, 14); o.w = NQ_PK4(9, 11, 13, 15);
            isum = __builtin_amdgcn_sdot4((int)o.x, 0x01010101, isum, false); isum = __builtin_amdgcn_sdot4((int)o.y, 0x01010101, isum, false);
            isum = __builtin_amdgcn_sdot4((int)o.z, 0x01010101, isum, false); isum = __builtin_amdgcn_sdot4((int)o.w, 0x01010101, isum, false);
            if (DOWN_SGN) {
                const unsigned h0 = ((o.x >> 4) & 0x0f0f0f0fu) | (o.y & 0xf0f0f0f0u), l0 = ((o.x & 0x0f0f0f0fu) | ((o.y << 4) & 0xf0f0f0f0u)) ^ 0x88888888u, h1 = ((o.z >> 4) & 0x0f0f0f0fu) | (o.w & 0xf0f0f0f0u), l1 = ((o.z & 0x0f0f0f0fu) | ((o.w << 4) & 0xf0f0f0f0u)) ^ 0x88888888u;
                o.x = h0; o.y = l0; o.z = h1; o.w = l1; }
            ((v4u*)(XQ + (size_t)row * DM))[c * 64 + lane] = o;
        }
#pragma unroll
        for (int o = 1; o < 64; o <<= 1) isum += __shfl_xor(isum, o);
        if (lane == 0) { XS[row] = mx / QMX; XSUM[row] = DOWN_SGN ? isum - 8 * DM : isum; }
    }
}
__device__ __forceinline__ void norm_rows(const float* X, const float* g, bf16* O, int gw, int ngw, int lane) {
    f32x4 v[16], vn[16];
    if (gw < T_TOK) { const f32x4* xr = (const f32x4*)(X + (size_t)gw * DM) + 2 * lane;
#pragma unroll
        for (int j = 0; j < 8; ++j) { v[2 * j] = __builtin_nontemporal_load(xr + 128 * j); v[2 * j + 1] = __builtin_nontemporal_load(xr + 128 * j + 1); } }
    for (int row = gw; row < T_TOK; row += ngw) {
        { const int rn = (row + ngw < T_TOK) ? row + ngw : row; const f32x4* xr = (const f32x4*)(X + (size_t)rn * DM) + 2 * lane;
#pragma unroll
          for (int j = 0; j < 8; ++j) { vn[2 * j] = __builtin_nontemporal_load(xr + 128 * j); vn[2 * j + 1] = __builtin_nontemporal_load(xr + 128 * j + 1); } }
        float ss = 0.f;
#pragma unroll
        for (int j = 0; j < 16; ++j) ss += (v[j].x * v[j].x + v[j].y * v[j].y) + (v[j].z * v[j].z + v[j].w * v[j].w);
        const float rstd = 1.0f / sqrtf(wave_sum(ss) * (1.0f / DM) + EPS);
        v4u* o16 = (v4u*)(O + (size_t)row * DM) + lane;
#pragma unroll
        for (int j = 0; j < 8; ++j) { const f32x4 g0 = ((const f32x4*)g)[128 * j + 2 * lane], g1 = ((const f32x4*)g)[128 * j + 2 * lane + 1]; const f32x4 a0 = v[2 * j], a1 = v[2 * j + 1];
            v4u o; o.x = pk2(a0.x * rstd * g0.x, a0.y * rstd * g0.y); o.y = pk2(a0.z * rstd * g0.z, a0.w * rstd * g0.w); o.z = pk2(a1.x * rstd * g1.x, a1.y * rstd * g1.y); o.w = pk2(a1.z * rstd * g1.z, a1.w * rstd * g1.w);
            o16[64 * j] = o; }
#pragma unroll
        for (int j = 0; j < 16; ++j) v[j] = vn[j];
    }
}

__device__ __forceinline__ void s5_tables(const Args& a, LAS unsigned char* lds, int g, int part, int tid);
__device__ __forceinline__ void phase_prologue(const Args& a, LAS unsigned char* lds, int tid, int lane, int wave) {
    unsigned char* ws = AWS;
    for (int i = blockIdx.x * NTHREADS + tid; i < 3 * T_TOK; i += gridDim.x * NTHREADS) ((float*)(ws + WS_RA))[i] = 0.f;
    { AMP_BEGIN(1); for (int u = blockIdx.x; u < 2 * NG; u += gridDim.x) s5_tables(a, lds, u & (NG - 1), u >> 7, tid); AMP_END(1); }
    LAS float* scr = (LAS float*)(lds + wave * 16640);
    const int gw = blockIdx.x * NWAVES + wave, ngw = gridDim.x * NWAVES;
#define PRO_TRANSPOSES() transposes_run(scr, gw, ngw, lane)
#define PRO_TABLES() do { convert_rows_i6<TB_D, DOWN_SGN, DOWN_SLICED>(AIN(I_DOWN), ws + WS_DOWN, (float*)(ws + WS_SDN), gw, ngw, lane); convert_rows_i6<TB_U, false, UP_SLICED>(AIN(I_UP), ws + WS_UP, (float*)(ws + WS_SUP), gw, ngw, lane); } while (0)
#define PRO_NORM() norm_rows(AIN(I_X), AIN(I_GMIX), (bf16*)(ws + WS_A1), gw, ngw, lane)
#ifndef TABLES_IN_TOPK
#define TABLES_IN_TOPK 1
#endif
    if (wave & 1) { PRO_NORM(); if (!TABLES_IN_TOPK) PRO_TABLES(); PRO_TRANSPOSES(); }
    else { { AMP_BEGIN(2); PRO_TRANSPOSES(); AMP_END(2); } if (!TABLES_IN_TOPK) PRO_TABLES(); { AMP_BEGIN(4); PRO_NORM(); AMP_END(4); } }
}


__device__ __forceinline__ void s5_tables(const Args& a, LAS unsigned char* lds, int g, int part, int tid) {
    LAS float* apr = (LAS float*)lds; LAS float* api = apr + 17 * 64; LAS float* bbr = api + 17 * 64; LAS float* bbi = bbr + 1024; LAS float* ccr = bbi + 1024; LAS float* cci = ccr + 1024;
    unsigned char* tb = AWS + WS_S5T + (size_t)g * S5T_STRIDE;
    for (int i = tid; i < 1024; i += NTHREADS) { ccr[i] = AIN(I_CRE)[(size_t)g * 1024 + i]; cci[i] = AIN(I_CIM)[(size_t)g * 1024 + i]; }
    if (tid < 64) { const int p = tid;
        const float lr = AIN(I_ARE)[g * 64 + p], li = AIN(I_AIM)[g * 64 + p], dt = expf(AIN(I_LOGDT)[g]);
        const float mag = expf(lr * dt); float sn, cs; sincos_poly(li * dt, sn, cs);
        const float ar = mag * cs, ai = mag * sn, nr = ar - 1.0f, ni = ai, den = lr * lr + li * li;
        const float cfr = (nr * lr + ni * li) / den, cfi = (ni * lr - nr * li) / den;
        float pr = 1.0f, pi = 0.0f;
        for (int j = 0; j <= 16; ++j) { apr[j * 64 + p] = pr; api[j * 64 + p] = pi; const float t = pr * ar - pi * ai; pi = pr * ai + pi * ar; pr = t; }
        for (int c = 0; c < 16; ++c) { const float br = AIN(I_BRE)[(size_t)(g * 64 + p) * 16 + c], bi = AIN(I_BIM)[(size_t)(g * 64 + p) * 16 + c];
            bbr[p * 16 + c] = cfr * br - cfi * bi; bbi[p * 16 + c] = cfr * bi + cfi * br; }
    }
    __syncthreads();
    if (part == 0 && tid < 64) { ((float*)(tb + S5T_A16))[tid] = apr[16 * 64 + tid]; ((float*)(tb + S5T_A16))[64 + tid] = api[16 * 64 + tid]; }
    bf16* Pm = (bf16*)(tb + S5T_PM); bf16* Qm = (bf16*)(tb + S5T_QM); bf16* Kt = (bf16*)(tb + S5T_K);
    if (part == 0) for (int idx = tid; idx < 64 * 256; idx += NTHREADS) { const int p = idx >> 8, k = idx & 255, s_ = k >> 4, cp = k & 15;
        const float ar = apr[(15 - s_) * 64 + p], ai = api[(15 - s_) * 64 + p], br = bbr[p * 16 + cp], bi = bbi[p * 16 + cp];
        Pm[p * 256 + k] = (bf16)(pk2(ar * br - ai * bi, 0.f) & 0xffffu); Pm[(64 + p) * 256 + k] = (bf16)(pk2(ar * bi + ai * br, 0.f) & 0xffffu); }
    if (part == 1) for (int idx = tid; idx < 256 * 64; idx += NTHREADS) { const int p = idx & 63, tc = idx >> 6, t = tc >> 4, c = tc & 15;
        const float cr = ccr[c * 64 + p], ci = cci[c * 64 + p], ar = apr[(t + 1) * 64 + p], ai = api[(t + 1) * 64 + p];
        Qm[tc * 128 + p] = (bf16)(pk2(cr * ar - ci * ai, 0.f) & 0xffffu); Qm[tc * 128 + 64 + p] = (bf16)(pk2(-(cr * ai + ci * ar), 0.f) & 0xffffu); }
    for (int idx = part * 2048 + tid; idx < part * 2048 + 2048; idx += NTHREADS) { const int d = idx >> 8, c = (idx >> 4) & 15, cp = idx & 15; float acc = 0.f;
#pragma unroll 8
        for (int p = 0; p < 64; ++p) { const float cr = ccr[c * 64 + p], ci = cci[c * 64 + p], ar = apr[d * 64 + p], ai = api[d * 64 + p];
            const float tr = cr * ar - ci * ai, ti = cr * ai + ci * ar; acc += tr * bbr[p * 16 + cp] - ti * bbi[p * 16 + cp]; }
        Kt[idx] = (bf16)(pk2(acc, 0.f) & 0xffffu); }
    __syncthreads();
}
constexpr int S5_PMP = 528, S5_QMP = 272, S5_LPM = 0, S5_LQM = 128 * S5_PMP, S5_LKT = S5_LQM + 256 * S5_QMP;
__device__ __forceinline__ void s5_unit(const Args& a, LAS unsigned char* lds, int g, int b0, int tid, int lane, int wave) {
    const unsigned char* tb = AWS + WS_S5T + (size_t)g * S5T_STRIDE;
    const bf16* Zg = (const bf16*)(AWS + WS_ZS5) + (size_t)g * T_TOK * 16; bf16* Y = (bf16*)(AWS + WS_YS5);
    float* Ews = (float*)(AWS + WS_S5E); bf16* Sws = (bf16*)(AWS + WS_S5S);
    AMP_ACC_DECL(); AMP_ACC_B(15);
#pragma unroll
    for (int it = 0; it < 8; ++it) { const int i = tid + NTHREADS * it;
        *(LAS v4u*)(lds + S5_LPM + (i >> 5) * S5_PMP + (i & 31) * 16) = ((const v4u*)(tb + S5T_PM))[i];
        *(LAS v4u*)(lds + S5_LQM + (i >> 4) * S5_QMP + (i & 15) * 16) = ((const v4u*)(tb + S5T_QM))[i]; }
    *(LAS v4u*)(lds + S5_LKT + tid * 16) = ((const v4u*)(tb + S5T_K))[tid];
    __syncthreads();
    AMP_ACC_E(15);
    const int fr = lane & 15, fq = lane >> 4;
#ifndef S5_NOE
    { AMP_BEGIN(11);
    bf16x8 ufe[8];
    { const size_t tok0 = (size_t)(b0 + (wave >> 4)) * SEQ + ((wave & 15) * 16 + fr) * 16;
#pragma unroll
      for (int ks = 0; ks < 8; ++ks) ufe[ks] = *(const bf16x8*)(Zg + (tok0 + 2 * ks + (fq >> 1)) * 16 + 8 * (fq & 1)); }
    for (int cb = wave; cb < 32; cb += 8) {
        const int b = b0 + (cb >> 4), chunk = (cb & 15) * 16 + fr;
        bf16x8 uf[8];
#pragma unroll
        for (int ks = 0; ks < 8; ++ks) uf[ks] = ufe[ks];
        { const int cn = (cb + 8 < 32) ? cb + 8 : cb; const size_t tokn = (size_t)(b0 + (cn >> 4)) * SEQ + ((cn & 15) * 16 + fr) * 16;
#pragma unroll
          for (int ks = 0; ks < 8; ++ks) ufe[ks] = *(const bf16x8*)(Zg + (tokn + 2 * ks + (fq >> 1)) * 16 + 8 * (fq & 1)); }
        float* ep = Ews + (((size_t)b * NG + g) * 256 + chunk) * 128 + 4 * fq;
#pragma unroll 2
        for (int rb = 0; rb < 8; ++rb) { f32x4 acc = (f32x4){0.f, 0.f, 0.f, 0.f};
#pragma unroll
            for (int ks = 0; ks < 8; ++ks) { const bf16x8 af = *(const LAS bf16x8*)(lds + S5_LPM + (16 * rb + fr) * S5_PMP + (32 * ks + 8 * fq) * 2); acc = __builtin_amdgcn_mfma_f32_16x16x32_bf16(af, uf[ks], acc, 0, 0, 0); }
            *(f32x4*)(ep + 16 * rb) = acc; }
    }
    AMP_END(11); }
#endif
    asm volatile("s_waitcnt vmcnt(0)" ::: "memory");
    __syncthreads();
#ifndef S5_NOR
    AMP_ACC_B(12);
    {
        const int b = b0 + (wave >> 2), seg = wave & 3, p = lane; const float a16r = ((const float*)(tb + S5T_A16))[p], a16i = ((const float*)(tb + S5T_A16))[64 + p];
        const float* Eb = Ews + (((size_t)b * NG + g) * 256 + seg * 64) * 128; bf16* Sb = Sws + (((size_t)b * NG + g) * 256 + seg * 64) * 128;
        float pr[64], pi[64]; float sr = 0.f, si = 0.f;
#pragma unroll
        for (int k0 = 0; k0 < 64; k0 += 16) { float er[16], ei[16];
#pragma unroll
            for (int j = 0; j < 16; ++j) { er[j] = Eb[(size_t)(k0 + j) * 128 + p]; ei[j] = Eb[(size_t)(k0 + j) * 128 + 64 + p]; }
#pragma unroll
            for (int j = 0; j < 16; ++j) { pr[k0 + j] = sr; pi[k0 + j] = si; const float nsr = a16r * sr - a16i * si + er[j], nsi = a16r * si + a16i * sr + ei[j]; sr = nsr; si = nsi; } }
        LAS float* xs = (LAS float*)(lds + S5_LPM);
        xs[((wave >> 2) * 4 + seg) * 128 + p] = sr; xs[((wave >> 2) * 4 + seg) * 128 + 64 + p] = si;
        float a64r = a16r, a64i = a16i;
#pragma unroll
        for (int q = 0; q < 6; ++q) { const float t = a64r * a64r - a64i * a64i; a64i = 2.0f * a64r * a64i; a64r = t; }
        __syncthreads();
        float cr = 0.f, ci = 0.f;
        for (int s2 = 0; s2 < seg; ++s2) { const float er = xs[((wave >> 2) * 4 + s2) * 128 + p], ei = xs[((wave >> 2) * 4 + s2) * 128 + 64 + p];
            const float t = a64r * cr - a64i * ci + er; ci = a64r * ci + a64i * cr + ei; cr = t; }
        float wr_ = 1.0f, wi_ = 0.0f;
#pragma unroll
        for (int j = 0; j < 64; ++j) { const float vr = pr[j] + wr_ * cr - wi_ * ci, vi = pi[j] + wr_ * ci + wi_ * cr;
            Sb[(size_t)j * 128 + p] = (bf16)(pk2(vr, 0.f) & 0xffffu); Sb[(size_t)j * 128 + 64 + p] = (bf16)(pk2(vi, 0.f) & 0xffffu);
            const float t = wr_ * a16r - wi_ * a16i; wi_ = wr_ * a16i + wi_ * a16r; wr_ = t; }
    }
#endif
    asm volatile("s_waitcnt vmcnt(0)" ::: "memory");
    __syncthreads();
    AMP_ACC_E(12);
#ifndef S5_NOY
    AMP_ACC_B(13);
    const f32x4 dsk = *(const f32x4*)(AIN(I_DSK) + g * 16 + 4 * fq);
    const int kbase = S5_LKT + fr * 32 + (fq & 1) * 16, qbase = S5_LQM + fr * S5_QMP + fq * 16, fh = fq >> 1;
    bf16x8 kfl[16];
#pragma unroll
    for (int M = 0; M < 16; ++M) { const int lag = M - fh; kfl[M] = *(const LAS bf16x8*)(lds + kbase + (lag < 0 ? 0 : lag) * 512); if (lag < 0) kfl[M] = (bf16x8){0, 0, 0, 0, 0, 0, 0, 0}; }
    for (int cb = wave; cb < 32; cb += 8) {
        const int b = b0 + (cb >> 4), chunk = (cb & 15) * 16 + fr; const size_t tok0 = (size_t)b * SEQ + chunk * 16;
        bf16x8 uf[8], spf[4];
#pragma unroll
        for (int ks = 0; ks < 8; ++ks) uf[ks] = *(const bf16x8*)(Zg + (tok0 + 2 * ks + (fq >> 1)) * 16 + 8 * (fq & 1));
#pragma unroll
        for (int kq = 0; kq < 4; ++kq) spf[kq] = *(const bf16x8*)(Sws + (((size_t)b * NG + g) * 256 + chunk) * 128 + 32 * kq + 8 * fq);
        const bf16* zp = Zg + tok0 * 16 + 4 * fq; bf16* yp = Y + tok0 * D_S5 + g * 16 + 4 * fq;
#define S5_YBODY(t, UW) do { f32x4 acc = (f32x4){0.f, 0.f, 0.f, 0.f}, acq = (f32x4){0.f, 0.f, 0.f, 0.f};        \
            _Pragma("unroll") for (int kq = 0; kq < 4; ++kq) { const bf16x8 qf = *(const LAS bf16x8*)(lds + qbase + (t) * (16 * S5_QMP) + kq * 64); acq = __builtin_amdgcn_mfma_f32_16x16x32_bf16(qf, spf[kq], acq, 0, 0, 0); } \
            _Pragma("unroll") for (int ks = 0; ks < 8; ++ks) if (2 * ks <= (t)) acc = __builtin_amdgcn_mfma_f32_16x16x32_bf16(kfl[(t) - 2 * ks], uf[ks], acc, 0, 0, 0); \
            acc += acq; \
            const float y0 = pg8::gelu_t(acc[0] + dsk[0] * bflo((UW).x)), y1 = pg8::gelu_t(acc[1] + dsk[1] * bfhi((UW).x)), y2 = pg8::gelu_t(acc[2] + dsk[2] * bflo((UW).y)), y3 = pg8::gelu_t(acc[3] + dsk[3] * bfhi((UW).y)); \
            v2u o; o.x = pk2(y0, y1); o.y = pk2(y2, y3); *(v2u*)(yp + (size_t)(t) * D_S5) = o; } while (0)
        v2u ua = *(const v2u*)zp, ub = *(const v2u*)(zp + 16);
#pragma unroll
        for (int t = 0; t < 16; t += 2) {
            S5_YBODY(t, ua); ua = *(const v2u*)(zp + (t + 2 < 16 ? t + 2 : 15) * 16);
            S5_YBODY(t + 1, ub); ub = *(const v2u*)(zp + (t + 3 < 16 ? t + 3 : 15) * 16);
        }
    }
    AMP_ACC_E(13);
#endif
    __syncthreads();
    AMP_ACC_SPIN(15); AMP_ACC_SPIN(12); AMP_ACC_SPIN(13);
}

constexpr int GM_PITCH = 272;
constexpr int GM_VT = 0, GM_WT = 256 * GM_PITCH, GM_ST = GM_WT + 128 * GM_PITCH;
__device__ __forceinline__ void gmlp_unit(const Args& a, LAS unsigned char* lds, int n, int h, bool stage_w, int tid, int lane, int wave) {
    const bf16* Z = (const bf16*)(AWS + WS_Z); bf16* MIX = (bf16*)(AWS + WS_MIX);
    const f32x2* statsV = (const f32x2*)(AWS + WS_STV); float* statsB = (float*)(AWS + WS_RB);
    const int tok0 = n * 128;
    LAS f32x2* st = (LAS f32x2*)(lds + GM_ST);
    AMP_ACC_DECL(); AMP_ACC_B(16);
    f32x2 sp8[8];
    { const f32x2* sp = statsV + (size_t)(tok0 + (tid >> 2)) * 32 + (tid & 3) * 8;
#pragma unroll
      for (int k = 0; k < 8; ++k) sp8[k] = sp[k]; }
    unsigned vw[4][8];
#pragma unroll
    for (int it = 0; it < 4; ++it) { const int item = tid + NTHREADS * it, dp = item & 127, jg = item >> 7;
#pragma unroll
        for (int r = 0; r < 8; ++r) vw[it][r] = *(const unsigned*)(Z + (size_t)(tok0 + jg * 8 + r) * NZG + 2048 + h * 256 + 2 * dp); }
    if (stage_w) {
        const int i = tid >> 2, j0 = (tid & 3) * 32; const float* wr = AIN(I_WS) + ((size_t)h * 128 + i) * 128 + j0;
#pragma unroll
        for (int q = 0; q < 4; ++q) { f32x4 x0 = ((const f32x4*)wr)[2 * q], x1 = ((const f32x4*)wr)[2 * q + 1];
            if (i < 64 && j0 + 8 * q >= 64) { x0 = (f32x4){0.f, 0.f, 0.f, 0.f}; x1 = x0; }
            v4u o; o.x = pk2(x0.x, x0.y); o.y = pk2(x0.z, x0.w); o.z = pk2(x1.x, x1.y); o.w = pk2(x1.z, x1.w);
            *(LAS v4u*)(lds + GM_WT + i * GM_PITCH + (j0 + 8 * q) * 2) = o; }
    }
    { float s = 0.f, q = 0.f;
#pragma unroll
      for (int k = 0; k < 8; ++k) { s += sp8[k].x; q += sp8[k].y; }
      s += __shfl_xor(s, 1); q += __shfl_xor(q, 1); s += __shfl_xor(s, 2); q += __shfl_xor(q, 2);
      const float mean = s * (1.0f / 2048.0f), var = q * (1.0f / 2048.0f) - mean * mean;
      if ((tid & 3) == 0) st[tid >> 2] = (f32x2){mean, 1.0f / sqrtf(var + EPS)}; }
    __syncthreads();
    AMP_ACC_E(16); AMP_ACC_B(17);
    {
#pragma unroll
        for (int it = 0; it < 4; ++it) { const int item = tid + NTHREADS * it, dp = item & 127, jg = item >> 7; const int col = h * 256 + 2 * dp;
            const float g0 = AIN(I_LNG)[col], g1 = AIN(I_LNG)[col + 1], b0 = AIN(I_LNB)[col], b1 = AIN(I_LNB)[col + 1];
            float x0[8], x1[8];
#pragma unroll
            for (int r = 0; r < 8; ++r) { const unsigned w = vw[it][r]; const f32x2 ms = st[jg * 8 + r];
                x0[r] = (bflo(w) - ms.x) * ms.y * g0 + b0; x1[r] = (bfhi(w) - ms.x) * ms.y * g1 + b1; }
            v4u o0, o1; o0.x = pk2(x0[0], x0[1]); o0.y = pk2(x0[2], x0[3]); o0.z = pk2(x0[4], x0[5]); o0.w = pk2(x0[6], x0[7]);
            o1.x = pk2(x1[0], x1[1]); o1.y = pk2(x1[2], x1[3]); o1.z = pk2(x1[4], x1[5]); o1.w = pk2(x1[6], x1[7]);
            *(LAS v4u*)(lds + GM_VT + (2 * dp) * GM_PITCH + jg * 16) = o0; *(LAS v4u*)(lds + GM_VT + (2 * dp + 1) * GM_PITCH + jg * 16) = o1; }
    }
    const int fr = lane & 15, fq = lane >> 4;
    v2u uw[8][2]; float bsv[8];
#pragma unroll
    for (int mt = 0; mt < 8; ++mt) { bsv[mt] = AIN(I_BS)[h * 128 + mt * 16 + fr];
#pragma unroll
        for (int nt = 0; nt < 2; ++nt) uw[mt][nt] = *(const v2u*)(Z + (size_t)(tok0 + mt * 16 + fr) * NZG + h * 256 + 32 * wave + 16 * nt + 4 * fq); }
    __syncthreads();
    AMP_ACC_E(17); AMP_ACC_B(18);
    bf16x8 vf[2][4];
#pragma unroll
    for (int nt = 0; nt < 2; ++nt)
#pragma unroll
        for (int ks = 0; ks < 4; ++ks) vf[nt][ks] = *(const LAS bf16x8*)(lds + GM_VT + (32 * wave + 16 * nt + fr) * GM_PITCH + (ks * 32 + 8 * fq) * 2);
#pragma unroll
    for (int mt = 0; mt < 8; ++mt) {
        bf16x8 wf[4];
#pragma unroll
        for (int ks = 0; ks < 4; ++ks) wf[ks] = *(const LAS bf16x8*)(lds + GM_WT + (mt * 16 + fr) * GM_PITCH + (ks * 32 + 8 * fq) * 2);
        f32x4 acc[2] = {(f32x4){0.f, 0.f, 0.f, 0.f}, (f32x4){0.f, 0.f, 0.f, 0.f}};
#pragma unroll
        for (int ks = 0; ks < 4; ++ks)
#pragma unroll
            for (int nt = 0; nt < 2; ++nt) acc[nt] = __builtin_amdgcn_mfma_f32_16x16x32_bf16(vf[nt][ks], wf[ks], acc[nt], 0, 0, 0);
        const size_t tok = (size_t)tok0 + mt * 16 + fr; const float bsi = bsv[mt]; float q = 0.f;
#pragma unroll
        for (int nt = 0; nt < 2; ++nt) { const int dcol = h * 256 + 32 * wave + 16 * nt + 4 * fq; const v2u u2 = uw[mt][nt];
            const float y0 = bflo(u2.x) * (acc[nt][0] + bsi), y1 = bfhi(u2.x) * (acc[nt][1] + bsi), y2 = bflo(u2.y) * (acc[nt][2] + bsi), y3 = bfhi(u2.y) * (acc[nt][3] + bsi);
            q += (y0 * y0 + y1 * y1) + (y2 * y2 + y3 * y3);
            v2u o; o.x = pk2(y0, y1); o.y = pk2(y2, y3); *(v2u*)(MIX + tok * DM + 2048 + dcol) = o; }
        q += __shfl_xor(q, 16); q += __shfl_xor(q, 32);
        if (fq == 0) atomicAdd(statsB + tok, q);
    }
    __syncthreads();
    AMP_ACC_E(18); AMP_ACC_SPIN(16); AMP_ACC_SPIN(17); AMP_ACC_SPIN(18);
}

constexpr int TK_KP = 272, TK_K2 = 128 * TK_KP, TK_SC = 2 * 128 * TK_KP, TK_SEL = TK_SC + 8 * 4096;
__device__ __forceinline__ int dpp_i(int x, const int ctrl_sel) {
    return ctrl_sel == 8 ? __builtin_amdgcn_update_dpp(0, x, 0x128, 0xf, 0xf, false) : ctrl_sel == 4 ? __builtin_amdgcn_update_dpp(0, x, 0x124, 0xf, 0xf, false)
         : ctrl_sel == 2 ? __builtin_amdgcn_update_dpp(0, x, 0x122, 0xf, 0xf, false) : __builtin_amdgcn_update_dpp(0, x, 0x121, 0xf, 0xf, false);
}
__device__ __forceinline__ int rowsum16_i(int x) { x += dpp_i(x, 8); x += dpp_i(x, 4); x += dpp_i(x, 2); x += dpp_i(x, 1); return x; }
__device__ __forceinline__ float rowsum16_f(float x) { x += __builtin_bit_cast(float, dpp_i(__builtin_bit_cast(int, x), 8)); x += __builtin_bit_cast(float, dpp_i(__builtin_bit_cast(int, x), 4));
    x += __builtin_bit_cast(float, dpp_i(__builtin_bit_cast(int, x), 2)); x += __builtin_bit_cast(float, dpp_i(__builtin_bit_cast(int, x), 1)); return x; }
__device__ __forceinline__ float rowmax16_f(float x) { x = fmaxf(x, __builtin_bit_cast(float, dpp_i(__builtin_bit_cast(int, x), 8))); x = fmaxf(x, __builtin_bit_cast(float, dpp_i(__builtin_bit_cast(int, x), 4)));
    x = fmaxf(x, __builtin_bit_cast(float, dpp_i(__builtin_bit_cast(int, x), 2))); x = fmaxf(x, __builtin_bit_cast(float, dpp_i(__builtin_bit_cast(int, x), 1))); return x; }
__device__ __forceinline__ unsigned fixkey(float s, float off, float scale) { const unsigned k = (unsigned)((s + off) * scale); return k > 0xffffu ? 0xffffu : k; }
__device__ __forceinline__ unsigned pk_sub_sat(unsigned a, unsigned b) { unsigned r; asm("v_pk_sub_u16 %0, %1, %2 clamp" : "=v"(r) : "v"(a), "v"(b)); return r; }
__device__ __forceinline__ unsigned pk_min(unsigned a, unsigned b) { unsigned r; asm("v_pk_min_u16 %0, %1, %2" : "=v"(r) : "v"(a), "v"(b)); return r; }
__device__ __forceinline__ unsigned pk_add(unsigned a, unsigned b) { unsigned r; asm("v_pk_add_u16 %0, %1, %2" : "=v"(r) : "v"(a), "v"(b)); return r; }
template <int NP> __device__ __forceinline__ unsigned group_threshold(const unsigned (&kp)[NP]) {
    unsigned T = 0u; bool done = false; unsigned ones = 0x00010001u; asm volatile("" : "+v"(ones));
    for (int bit = 15; bit >= 0; --bit) { const unsigned tr = T | (1u << bit); const unsigned tm = (tr - 1u) * 0x00010001u; unsigned c = 0u;
#pragma unroll
        for (int i = 0; i < NP; ++i) c = pk_add(c, pk_min(pk_sub_sat(kp[i], tm), ones));
        const int cnt = rowsum16_i((int)((c & 0xffffu) + (c >> 16)));
        T = (!done && cnt >= 16) ? tr : T; done = done || (cnt == 16);
        if (__ballot(!done) == 0ull) break; }
    return T;
}
constexpr int TK_WSEL = 3072;
__device__ __forceinline__ void phase_topk(const Args& a, LAS unsigned char* lds, int tid, int lane, int wave) {
    LAS float* selv = (LAS float*)(lds + TK_SC + wave * TK_WSEL); LAS int* seli = (LAS int*)(selv + 192); LAS float* fins = selv + 384; LAS int* fine = (LAS int*)(selv + 512);
    {
        const int n = tid >> 2, d0 = (tid & 3) * 32;
#pragma unroll
        for (int tb = 0; tb < 2; ++tb) { const float* kr = AIN(tb ? I_K2 : I_K1) + n * 128 + d0;
#pragma unroll
            for (int q = 0; q < 4; ++q) { const f32x4 x0 = ((const f32x4*)kr)[2 * q], x1 = ((const f32x4*)kr)[2 * q + 1];
                v4u o; o.x = pk2(x0.x, x0.y); o.y = pk2(x0.z, x0.w); o.z = pk2(x1.x, x1.y); o.w = pk2(x1.z, x1.w);
                *(LAS v4u*)(lds + tb * TK_K2 + n * TK_KP + (d0 + 8 * q) * 2) = o; } }
    }
    __syncthreads();
    const bf16* Q = (const bf16*)(AWS + WS_Z); int* IDX = (int*)(AWS + WS_IDX); float* GATE = (float*)(AWS + WS_GATE);
    const int fr = lane & 15, fq = lane >> 4; const unsigned below = (1u << fr) - 1u;
    const int gw = blockIdx.x * NWAVES + wave, ngw = gridDim.x * NWAVES;
    AMP_ACC_DECL();
    const bool conv_first = wave < 4; const int niter = (T_TOK / 16 - (int)blockIdx.x + (int)gridDim.x - 1) / (int)gridDim.x, nsteps = 2 * (niter > 4 ? niter : 4);
#pragma unroll 1
    for (int s2 = 0; s2 < nsteps; ++s2) {
        const int cslice = s2 >> 1;
        if (((s2 & 1) == 0) == conv_first) {
            if (TABLES_IN_TOPK && cslice < 4) {
                AMP_ACC_B(80);
                if (cslice < 2) convert_rows_i6<TB_D, DOWN_SGN, DOWN_SLICED>(AIN(I_DOWN), AWS + WS_DOWN, (float*)(AWS + WS_SDN), gw + (NEXP / 2) * cslice, ngw, lane, (NEXP / 2) * (cslice + 1));
                else convert_rows_i6<TB_U, false, UP_SLICED>(AIN(I_UP), AWS + WS_UP, (float*)(AWS + WS_SUP), gw + (NEXP / 2) * (cslice - 2), ngw, lane, (NEXP / 2) * (cslice - 1));
                norm_rows_q((const bf16*)(AWS + WS_HB), AIN(I_GFFN), AWS + WS_XQ, (float*)(AWS + WS_XS), (int*)(AWS + WS_XSUM), gw + (T_TOK / 4) * cslice, ngw, lane, (T_TOK / 4) * (cslice + 1)); AMP_ACC_E(80); }
            continue; }
        const int tg = blockIdx.x + cslice * gridDim.x; if (tg >= T_TOK / 16) continue;
        const int tok0 = tg * 16;
        AMP_ACC_B(81);
        f32x4 acc[2][8];
#pragma unroll
        for (int hf = 0; hf < 2; ++hf)
#pragma unroll
            for (int nt = 0; nt < 8; ++nt) acc[hf][nt] = (f32x4){0.f, 0.f, 0.f, 0.f};
#pragma unroll
        for (int hf = 0; hf < 2; ++hf)
#pragma unroll
            for (int ks = 0; ks < 4; ++ks) { const bf16x8 af = *(const bf16x8*)(Q + (size_t)(tok0 + fr) * 2048 + wave * 256 + hf * 128 + 32 * ks + 8 * fq);
#pragma unroll
                for (int nt = 0; nt < 8; ++nt) { const bf16x8 kf = *(const LAS bf16x8*)(lds + hf * TK_K2 + (nt * 16 + fr) * TK_KP + (32 * ks + 8 * fq) * 2);
                    acc[hf][nt] = __builtin_amdgcn_mfma_f32_16x16x32_bf16(af, kf, acc[hf][nt], 0, 0, 0); } }
#pragma unroll
        for (int r = 0; r < 4; ++r) {
#pragma unroll
            for (int hf = 0; hf < 2; ++hf) {
                unsigned k[8], kp[4];
#pragma unroll
                for (int nt = 0; nt < 8; ++nt) k[nt] = fixkey(acc[hf][nt][r], 8.0f, 4096.0f);
#pragma unroll
                for (int i = 0; i < 4; ++i) kp[i] = k[2 * i] | (k[2 * i + 1] << 16);
                const unsigned T = group_threshold<4>(kp); int base = 0;
#pragma unroll
                for (int nt = 0; nt < 8; ++nt) { const bool sel = k[nt] >= T; const unsigned sl = (unsigned)(__ballot(sel) >> (16 * fq)) & 0xffffu; const int pos = base + __popc(sl & below);
                    const int dst = (sel && pos < 16) ? (fq * 2 + hf) * 16 + pos : 128 + lane; selv[dst] = acc[hf][nt][r]; seli[dst] = nt * 16 + fr;
                    base += __popc(sl); }
            }
            {
                const float v1 = selv[(fq * 2) * 16 + fr]; const int i1 = seli[(fq * 2) * 16 + fr]; float cv[16]; unsigned kc[16], kcp[8];
#pragma unroll
                for (int j = 0; j < 16; ++j) { cv[j] = v1 + selv[(fq * 2 + 1) * 16 + j]; kc[j] = fixkey(cv[j], 16.0f, 2048.0f); }
#pragma unroll
                for (int i = 0; i < 8; ++i) kcp[i] = kc[2 * i] | (kc[2 * i + 1] << 16);
                const unsigned T2 = group_threshold<8>(kcp); int base = 0;
#pragma unroll
                for (int j = 0; j < 16; ++j) { const bool sel = kc[j] >= T2; const unsigned sl = (unsigned)(__ballot(sel) >> (16 * fq)) & 0xffffu; const int pos = base + __popc(sl & below);
                    const int dst = (sel && pos < 16) ? fq * 16 + pos : 64 + lane; fins[dst] = cv[j]; fine[dst] = i1 * 128 + seli[(fq * 2 + 1) * 16 + j];
                    base += __popc(sl); }
            }
            {
                const float s_ = fins[fq * 16 + fr]; const float m = rowmax16_f(s_); const float e = __expf(s_ - m); const float z = rowsum16_f(e);
                const size_t t = (size_t)tok0 + 4 * fq + r;
                IDX[t * 128 + wave * 16 + fr] = fine[fq * 16 + fr]; GATE[t * 128 + wave * 16 + fr] = e / z;
            }
        }
        AMP_ACC_E(81);
    }
    AMP_ACC_SPIN(80); AMP_ACC_SPIN(81);
}

template <int BITS> struct RowBufT { v4u n0, n1, h; };
template <> struct RowBufT<5> { v4u n0, n1; v2u h; };
template <> struct RowBufT<4> { v4u n0, n1; };
typedef RowBufT<(TB_D > TB_U ? TB_D : TB_U)> RowBuf;
template <int BITS, class RB> __device__ __forceinline__ void row_load(RB& dst, const unsigned char* rb_, int lane) {
    dst.n0 = ((const v4u*)rb_)[lane]; dst.n1 = ((const v4u*)rb_)[64 + lane];
    if constexpr (BITS == 6) dst.h = ((const v4u*)rb_)[128 + lane]; else if constexpr (BITS == 5) { const v2u h_ = ((const v2u*)(rb_ + 2048))[lane]; dst.h.x = h_.x; dst.h.y = h_.y; }
}
#ifndef PG_HALF
#define PG_HALF 0
#endif
#define ROW_LOAD_B(BITS, dst, base, e) do { if constexpr (LO && PG_HALF) { const unsigned char* rb_ = (base) + (size_t)(e) * rowb_of(BITS); dst.n0 = ((const v4u*)rb_)[lane]; dst.n1 = dst.n0 * 3u; } else row_load<BITS>(dst, (base) + (size_t)(e) * rowb_of(BITS), lane); } while (0)
template <int BITS, int C, class RB> __device__ __forceinline__ void row_decode(const RB& B, unsigned& g0, unsigned& g1, unsigned& g2, unsigned& g3) {
    g0 = B.n0[C] & 0x0f0f0f0fu; g1 = (B.n0[C] >> 4) & 0x0f0f0f0fu; g2 = B.n1[C] & 0x0f0f0f0fu; g3 = (B.n1[C] >> 4) & 0x0f0f0f0fu;
    if constexpr (BITS == 6) { const unsigned hw_ = B.h[C]; g0 |= (hw_ >> 2) & 0x30303030u; g1 |= (hw_ << 2) & 0x30303030u; g2 |= hw_ & 0x30303030u; g3 |= (hw_ << 4) & 0x30303030u; }
    else if constexpr (BITS == 5) { const unsigned hw_ = (C < 2) ? B.h.x : B.h.y;
        g0 |= ((C & 1) ? hw_ : (hw_ << 4)) & 0x10101010u; g1 |= ((C & 1) ? (hw_ >> 1) : (hw_ << 3)) & 0x10101010u; g2 |= ((C & 1) ? (hw_ >> 2) : (hw_ << 2)) & 0x10101010u; g3 |= ((C & 1) ? (hw_ >> 3) : (hw_ << 1)) & 0x10101010u; }
}
constexpr int toff2_of(int bits) { return bits == 6 ? 64 : bits == 5 ? 31 : 15; }
#define ROW_LOAD_SEL(dst, is_down, e) do { if (TB_D == TB_U) { const unsigned char* tb_ = (is_down) ? DOWN : UP; ROW_LOAD_B(TB_D, dst, tb_, e); } else if (is_down) ROW_LOAD_B(TB_D, dst, DOWN, e); else ROW_LOAD_B(TB_U, dst, UP, e); } while (0)
__device__ __forceinline__ void fmac_s(float& acc, float a, float b) { asm("v_fmac_f32 %0, %1, %2" : "+v"(acc) : "v"(a), "v"(b)); }
#define I6_AX(G, E0) do { fmac_s(acc[(E0)], act, (float)((G) & 255u)); fmac_s(acc[(E0) + 2], act, (float)(((G) >> 8) & 255u)); \
        fmac_s(acc[(E0) + 4], act, (float)(((G) >> 16) & 255u)); fmac_s(acc[(E0) + 6], act, (float)((G) >> 24)); } while (0)
#ifndef PG_SB
#define PG_SB __builtin_amdgcn_sched_barrier(0)
#endif
#define P1_CHUNK(B, C) do { if constexpr (LO) { idot ^= (int)(B.n0[C] ^ B.n1[C]); } else { const v4u xv_ = *(const LAS v4u*)(lds + xo_ + (C) * 1024); unsigned g0_, g1_, g2_, g3_; row_decode<TB_D, C>(B, g0_, g1_, g2_, g3_); \
            idot = __builtin_amdgcn_sdot4((int)g0_, (int)xv_.x, idot, false); idot = __builtin_amdgcn_sdot4((int)g1_, (int)xv_.y, idot, false); idot = __builtin_amdgcn_sdot4((int)g2_, (int)xv_.z, idot, false); idot = __builtin_amdgcn_sdot4((int)g3_, (int)xv_.w, idot, false); } } while (0)
#define P2_CHUNK(B, C) do { unsigned g0_, g1_, g2_, g3_; row_decode<TB_U, C>(B, g0_, g1_, g2_, g3_); I6_AX(g0_, (C) * 16); I6_AX(g1_, (C) * 16 + 1); I6_AX(g2_, (C) * 16 + 8); I6_AX(g3_, (C) * 16 + 9); } while (0)
#define P1_STEP(B, J, DP) do { int idot = 0; { int xo_ = xoff; asm volatile("" : "+v"(xo_));   \
        P1_CHUNK(B, 0); P1_CHUNK(B, 1); P1_CHUNK(B, 2); P1_CHUNK(B, 3); } \
        DP = idot; \
        { const int e_ = __builtin_amdgcn_readlane(eall, (8 * k8 + 8 + (J)) & 15); ROW_LOAD_SEL(B, dn1, e_); } PG_SB; } while (0)
#define P2_STEP(B, J) do { const float act = __builtin_bit_cast(float, __builtin_amdgcn_readlane(__builtin_bit_cast(int, actv), 16 * ((J) & 3) + 4 * (2 * k8 + ((J) >> 2)))); \
        P2_CHUNK(B, 0); P2_CHUNK(B, 1); P2_CHUNK(B, 2); P2_CHUNK(B, 3); \
        { const int e_ = __builtin_amdgcn_readlane(esrc, (8 * k8 + 8 + (J)) & 15); ROW_LOAD_SEL(B, dn2, e_); } PG_SB; } while (0)
constexpr int PG_RED = 8 * 4096 * 4, PG_X = PG_RED + 64;
template <bool LO> __device__ __forceinline__ void phase_gather(const Args& a, LAS unsigned char* lds, int tid, int lane, int wave) {
    LAS float* part = (LAS float*)lds; LAS float* red = (LAS float*)(lds + PG_RED);
    const unsigned char* XQ = AWS + WS_XQ; const unsigned char* DOWN = AWS + WS_DOWN; const unsigned char* UP = AWS + WS_UP;
    const float* SDN = (const float*)(AWS + WS_SDN); const float* SUP = (const float*)(AWS + WS_SUP); const float* XS = (const float*)(AWS + WS_XS); const int* XSUM = (const int*)(AWS + WS_XSUM);
    const int* IDX = (const int*)(AWS + WS_IDX); const float* GATE = (const float*)(AWS + WS_GATE);
    int t = blockIdx.x; if (t >= T_TOK) return;
    int eall = IDX[(size_t)t * 128 + wave * 16 + (lane & 15)]; float gall = GATE[(size_t)t * 128 + wave * 16 + (lane & 15)];
    RowBuf b0, b1, b2, b3, b4, b5, b6, b7;
    { ROW_LOAD_B(TB_D, b0, DOWN, __builtin_amdgcn_readlane(eall, 0)); ROW_LOAD_B(TB_D, b1, DOWN, __builtin_amdgcn_readlane(eall, 1)); ROW_LOAD_B(TB_D, b2, DOWN, __builtin_amdgcn_readlane(eall, 2)); ROW_LOAD_B(TB_D, b3, DOWN, __builtin_amdgcn_readlane(eall, 3));
      ROW_LOAD_B(TB_D, b4, DOWN, __builtin_amdgcn_readlane(eall, 4)); ROW_LOAD_B(TB_D, b5, DOWN, __builtin_amdgcn_readlane(eall, 5)); ROW_LOAD_B(TB_D, b6, DOWN, __builtin_amdgcn_readlane(eall, 6)); ROW_LOAD_B(TB_D, b7, DOWN, __builtin_amdgcn_readlane(eall, 7)); }
    const int xoff = PG_X + lane * 16;
    if (tid < 256) *(LAS v4u*)(lds + PG_X + tid * 16) = ((const v4u*)(XQ + (size_t)t * DM))[tid];
    __syncthreads();
    const bool h5 = lane & 32, h4 = lane & 16;
    for (; t < T_TOK; t += gridDim.x) {
        const int tn = t + gridDim.x; const size_t tq = (tn < T_TOK) ? (size_t)tn : (size_t)t;
        int lanev = lane; asm volatile("" : "+v"(lanev));
        const int eall_n = IDX[tq * 128 + wave * 16 + (lanev & 15)]; const float gall_n = GATE[tq * 128 + wave * 16 + (lanev & 15)];
        const float sdn = SDN[eall] * XS[t], sup = SUP[eall]; const int xsum = XSUM[t];
        float actv = 0.f;
#define P1_REDUCE(d0, d1, d2, d3, K4) do {   \
            const int s0_ = h5 ? d0 : d2, k0_ = h5 ? d2 : d0, s1_ = h5 ? d1 : d3, k1_ = h5 ? d3 : d1; \
            const int w0_ = k0_ + __shfl_xor(s0_, 32), w1_ = k1_ + __shfl_xor(s1_, 32); \
            int y_ = (h4 ? w1_ : w0_) + __shfl_xor(h4 ? w0_ : w1_, 16); \
            y_ += __shfl_xor(y_, 8); y_ += __shfl_xor(y_, 4); y_ += __shfl_xor(y_, 2); y_ += __shfl_xor(y_, 1); \
            const int ej_ = 4 * (K4) + (lanev >> 4); \
            const float dotv_ = (float)(2 * y_ - toff2_of(TB_D) * xsum) * 0.5f * __shfl(sdn, ej_);        \
            const float av_ = pg8::gelu_t(dotv_) * __shfl(gall, ej_) * __shfl(sup, ej_); \
            actv = (((lanev >> 2) & 3) == (K4)) ? av_ : actv; } while (0)
        static_assert(TB_D == TB_U, "the 8-buffer stream needs one row format (refills select the table by pointer, never by a branch around the loads)");
#pragma unroll 1
        for (int k8 = 0; k8 < 2; ++k8) {
            const bool dn1 = k8 < 1; int d0, d1, d2, d3, d4, d5, d6, d7;
            P1_STEP(b0, 0, d0); P1_STEP(b1, 1, d1); P1_STEP(b2, 2, d2); P1_STEP(b3, 3, d3); P1_STEP(b4, 4, d4); P1_STEP(b5, 5, d5); P1_STEP(b6, 6, d6); P1_STEP(b7, 7, d7);
            P1_REDUCE(d0, d1, d2, d3, 2 * k8); P1_REDUCE(d4, d5, d6, d7, 2 * k8 + 1);
        }
        const float amax = wave_max(fabsf(actv)); const float sa = amax * (1.0f / 127.0f), ainv = amax > 0.f ? 127.0f / amax : 0.f;
        const int aq = (int)rintf(actv * ainv);
        int aqs = aq;
#pragma unroll
        for (int o = 1; o < 64; o <<= 1) aqs += __shfl_xor(aqs, o);
        aqs >>= 2;
        int tid2 = tid; asm volatile("" : "+v"(tid2));
        const v4u xq = ((const v4u*)(XQ + tq * DM))[tid2 & 255];
        const v4u hw = __builtin_nontemporal_load((const v4u*)((const bf16*)(AWS + WS_HB) + (size_t)t * DM + tid2 * 8));
        int iacc[64];
#pragma unroll
        for (int i = 0; i < 64; ++i) iacc[i] = 0;
#define P2_T4(G0, G1, G2, G3, E0) do {   \
            const unsigned tl01_ = __builtin_amdgcn_perm(G1, G0, 0x05010400u), th01_ = __builtin_amdgcn_perm(G1, G0, 0x07030602u), tl23_ = __builtin_amdgcn_perm(G3, G2, 0x05010400u), th23_ = __builtin_amdgcn_perm(G3, G2, 0x07030602u); \
            iacc[(E0)] = __builtin_amdgcn_sdot4((int)__builtin_amdgcn_perm(tl23_, tl01_, 0x05040100u), a4, iacc[(E0)], false); \
            iacc[(E0) + 2] = __builtin_amdgcn_sdot4((int)__builtin_amdgcn_perm(tl23_, tl01_, 0x07060302u), a4, iacc[(E0) + 2], false); \
            iacc[(E0) + 4] = __builtin_amdgcn_sdot4((int)__builtin_amdgcn_perm(th23_, th01_, 0x05040100u), a4, iacc[(E0) + 4], false); \
            iacc[(E0) + 6] = __builtin_amdgcn_sdot4((int)__builtin_amdgcn_perm(th23_, th01_, 0x07060302u), a4, iacc[(E0) + 6], false); } while (0)
#define P2_C4(BA, BB, BC, BD, C) do { if constexpr (LO) { iacc[C] ^= (int)(BA.n0[C] ^ BA.n1[C] ^ BB.n0[C] ^ BB.n1[C] ^ BC.n0[C] ^ BC.n1[C] ^ BD.n0[C] ^ BD.n1[C]) + a4; } else { unsigned ga_[4], gb_[4], gc_[4], gd_[4]; \
            row_decode<TB_U, C>(BA, ga_[0], ga_[1], ga_[2], ga_[3]); row_decode<TB_U, C>(BB, gb_[0], gb_[1], gb_[2], gb_[3]); row_decode<TB_U, C>(BC, gc_[0], gc_[1], gc_[2], gc_[3]); row_decode<TB_U, C>(BD, gd_[0], gd_[1], gd_[2], gd_[3]); \
            P2_T4(ga_[0], gb_[0], gc_[0], gd_[0], (C) * 16); P2_T4(ga_[1], gb_[1], gc_[1], gd_[1], (C) * 16 + 1); P2_T4(ga_[2], gb_[2], gc_[2], gd_[2], (C) * 16 + 8); P2_T4(ga_[3], gb_[3], gc_[3], gd_[3], (C) * 16 + 9); } } while (0)
#define P2_GROUP(BA, BB, BC, BD, G4, JB) do { \
            const int a4 = (__builtin_amdgcn_readlane(aq, 4 * (G4)) & 255) | ((__builtin_amdgcn_readlane(aq, 16 + 4 * (G4)) & 255) << 8) | ((__builtin_amdgcn_readlane(aq, 32 + 4 * (G4)) & 255) << 16) | (__builtin_amdgcn_readlane(aq, 48 + 4 * (G4)) << 24); \
            P2_C4(BA, BB, BC, BD, 0); PG_SB; P2_C4(BA, BB, BC, BD, 1); PG_SB; P2_C4(BA, BB, BC, BD, 2); PG_SB; P2_C4(BA, BB, BC, BD, 3); PG_SB; \
            { const int e_ = __builtin_amdgcn_readlane(esrc, (8 * k8 + 8 + (JB)) & 15); ROW_LOAD_SEL(BA, dn2, e_); } { const int e_ = __builtin_amdgcn_readlane(esrc, (8 * k8 + 9 + (JB)) & 15); ROW_LOAD_SEL(BB, dn2, e_); } \
            { const int e_ = __builtin_amdgcn_readlane(esrc, (8 * k8 + 10 + (JB)) & 15); ROW_LOAD_SEL(BC, dn2, e_); } { const int e_ = __builtin_amdgcn_readlane(esrc, (8 * k8 + 11 + (JB)) & 15); ROW_LOAD_SEL(BD, dn2, e_); } } while (0)
#pragma unroll 1
        for (int k8 = 0; k8 < 2; ++k8) {
            const bool dn2 = !(k8 < 1); const int esrc = (k8 < 1) ? eall : eall_n;
            P2_GROUP(b0, b1, b2, b3, 2 * k8, 0); P2_GROUP(b4, b5, b6, b7, 2 * k8 + 1, 4);
        }
        const int ioff2 = toff2_of(TB_U) * aqs;
        const float sa2 = 0.5f * sa;
#pragma unroll
        for (int c = 0; c < 4; ++c) {
#pragma unroll
            for (int q = 0; q < 4; ++q) *(LAS f32x4*)(part + wave * 4096 + 4 * (lanev + 64 * (4 * c + q))) = (f32x4){(float)(2 * iacc[c * 16 + 4 * q] - ioff2) * sa2, (float)(2 * iacc[c * 16 + 4 * q + 1] - ioff2) * sa2, (float)(2 * iacc[c * 16 + 4 * q + 2] - ioff2) * sa2, (float)(2 * iacc[c * 16 + 4 * q + 3] - ioff2) * sa2}; }
        __syncthreads();
        if (tid2 < 256) *(LAS v4u*)(lds + PG_X + tid2 * 16) = xq;
        f32x4 v0 = (f32x4){bflo(hw.x), bfhi(hw.x), bflo(hw.y), bfhi(hw.y)}, v1 = (f32x4){bflo(hw.z), bfhi(hw.z), bflo(hw.w), bfhi(hw.w)};
#pragma unroll
        for (int w = 0; w < 8; ++w) { v0 += *(const LAS f32x4*)(part + w * 4096 + tid2 * 8); v1 += *(const LAS f32x4*)(part + w * 4096 + tid2 * 8 + 4); }
        float ss = (v0.x * v0.x + v0.y * v0.y) + (v0.z * v0.z + v0.w * v0.w) + (v1.x * v1.x + v1.y * v1.y) + (v1.z * v1.z + v1.w * v1.w);
        ss = wave_sum(ss);
        if (lanev == 0) red[wave] = ss;
        __syncthreads();
        float tot = 0.f;
#pragma unroll
        for (int w = 0; w < 8; ++w) tot += red[w];
        const float rstd = 1.0f / sqrtf(tot * (1.0f / DM) + EPS);
        const f32x4 g0 = *(const f32x4*)(AIN(I_GFIN) + tid2 * 8), g1 = *(const f32x4*)(AIN(I_GFIN) + tid2 * 8 + 4);
        int tid3 = tid; asm volatile("" : "+v"(tid3));
        float* orow = AOUT + (size_t)t * DM + tid3 * 8;
        __builtin_nontemporal_store(v0 * rstd * g0, (f32x4*)orow); __builtin_nontemporal_store(v1 * rstd * g1, (f32x4*)(orow + 4));
        eall = eall_n; gall = gall_n;
    }
}

__device__ __forceinline__ void phase_gather_s(const Args& a, LAS unsigned char* lds, int tid, int lane, int wave) {
    constexpr bool LO = false;
    LAS float* part = (LAS float*)lds; LAS float* red = (LAS float*)(lds + PG_RED);
    const unsigned char* XQ = AWS + WS_XQ; const unsigned char* DOWN = AWS + WS_DOWN; const unsigned char* UP = AWS + WS_UP;
    const float* SDN = (const float*)(AWS + WS_SDN); const float* SUP = (const float*)(AWS + WS_SUP); const float* XS = (const float*)(AWS + WS_XS); const int* XSUM = (const int*)(AWS + WS_XSUM);
    const int* IDX = (const int*)(AWS + WS_IDX); const float* GATE = (const float*)(AWS + WS_GATE); float* ACT = (float*)(AWS + WS_STV);
    if ((int)blockIdx.x >= T_TOK) return;
    const bool h5 = lane & 32, h4 = lane & 16;
    RowBuf b0, b1, b2, b3, b4, b5, b6, b7;
    {
    int t = blockIdx.x;
    int eall = IDX[(size_t)t * 128 + wave * 16 + (lane & 15)]; float gall = GATE[(size_t)t * 128 + wave * 16 + (lane & 15)];
    { ROW_LOAD_B(TB_D, b0, DOWN, __builtin_amdgcn_readlane(eall, 0)); ROW_LOAD_B(TB_D, b1, DOWN, __builtin_amdgcn_readlane(eall, 1)); ROW_LOAD_B(TB_D, b2, DOWN, __builtin_amdgcn_readlane(eall, 2)); ROW_LOAD_B(TB_D, b3, DOWN, __builtin_amdgcn_readlane(eall, 3));
      ROW_LOAD_B(TB_D, b4, DOWN, __builtin_amdgcn_readlane(eall, 4)); ROW_LOAD_B(TB_D, b5, DOWN, __builtin_amdgcn_readlane(eall, 5)); ROW_LOAD_B(TB_D, b6, DOWN, __builtin_amdgcn_readlane(eall, 6)); ROW_LOAD_B(TB_D, b7, DOWN, __builtin_amdgcn_readlane(eall, 7)); }
    if (tid < 256) *(LAS v4u*)(lds + tid * 16) = ((const v4u*)(XQ + (size_t)t * DM))[tid];
    __syncthreads();
    int par = 0;
#define S1_STEP(B, J, DP) do { int idot = 0; { int xo_ = xoff; asm volatile("" : "+v"(xo_)); P1_CHUNK(B, 0); P1_CHUNK(B, 1); P1_CHUNK(B, 2); P1_CHUNK(B, 3); } \
        DP = idot; \
        { const int e_ = __builtin_amdgcn_readlane(esrc1, (8 * k8 + 8 + (J)) & 15); ROW_LOAD_B(TB_D, B, DOWN, e_); } PG_SB; } while (0)
    for (; t < T_TOK; t += gridDim.x, par ^= 1) {
        const int tn = t + gridDim.x; const size_t tq = (tn < T_TOK) ? (size_t)tn : (size_t)t;
        int lanev = lane; asm volatile("" : "+v"(lanev));
        const int eall_n = IDX[tq * 128 + wave * 16 + (lanev & 15)]; const float gall_n = GATE[tq * 128 + wave * 16 + (lanev & 15)];
        const float sdn = SDN[eall] * XS[t], sup = SUP[eall]; const int xsum = XSUM[t];
        int tid2 = tid; asm volatile("" : "+v"(tid2));
        const v4u xq = ((const v4u*)(XQ + tq * DM))[tid2 & 255];
        const int xoff = par * 4096 + lanev * 16;
        float actv = 0.f;
#pragma unroll 1
        for (int k8 = 0; k8 < 2; ++k8) {
            const int esrc1 = (k8 < 1) ? eall : eall_n; int d0, d1, d2, d3, d4, d5, d6, d7;
            S1_STEP(b0, 0, d0); S1_STEP(b1, 1, d1); S1_STEP(b2, 2, d2); S1_STEP(b3, 3, d3); S1_STEP(b4, 4, d4); S1_STEP(b5, 5, d5); S1_STEP(b6, 6, d6); S1_STEP(b7, 7, d7);
            P1_REDUCE(d0, d1, d2, d3, 2 * k8); P1_REDUCE(d4, d5, d6, d7, 2 * k8 + 1);
        }
        if ((lanev & 3) == 0) ACT[(size_t)t * 128 + wave * 16 + 4 * ((lanev >> 2) & 3) + (lanev >> 4)] = actv;
        if (tid2 < 256) *(LAS v4u*)(lds + (par ^ 1) * 4096 + tid2 * 16) = xq;
        __syncthreads();
        eall = eall_n; gall = gall_n;
    }
    }
    {
    int t = blockIdx.x;
    int eall = IDX[(size_t)t * 128 + wave * 16 + (lane & 15)];
    { ROW_LOAD_B(TB_U, b0, UP, __builtin_amdgcn_readlane(eall, 0)); ROW_LOAD_B(TB_U, b1, UP, __builtin_amdgcn_readlane(eall, 1)); ROW_LOAD_B(TB_U, b2, UP, __builtin_amdgcn_readlane(eall, 2)); ROW_LOAD_B(TB_U, b3, UP, __builtin_amdgcn_readlane(eall, 3));
      ROW_LOAD_B(TB_U, b4, UP, __builtin_amdgcn_readlane(eall, 4)); ROW_LOAD_B(TB_U, b5, UP, __builtin_amdgcn_readlane(eall, 5)); ROW_LOAD_B(TB_U, b6, UP, __builtin_amdgcn_readlane(eall, 6)); ROW_LOAD_B(TB_U, b7, UP, __builtin_amdgcn_readlane(eall, 7)); }
    for (; t < T_TOK; t += gridDim.x) {
        const int tn = t + gridDim.x; const size_t tq = (tn < T_TOK) ? (size_t)tn : (size_t)t;
        int lanev = lane; asm volatile("" : "+v"(lanev));
        const int eall_n = IDX[tq * 128 + wave * 16 + (lanev & 15)];
        const float actv = ACT[(size_t)t * 128 + wave * 16 + 4 * ((lanev >> 2) & 3) + (lanev >> 4)];
        const float amax = wave_max(fabsf(actv)); const float sa = amax * (1.0f / 127.0f), ainv = amax > 0.f ? 127.0f / amax : 0.f;
        const int aq = (int)rintf(actv * ainv);
        int aqs = aq;
#pragma unroll
        for (int o = 1; o < 64; o <<= 1) aqs += __shfl_xor(aqs, o);
        aqs >>= 2;
        int tid2 = tid; asm volatile("" : "+v"(tid2));
        const v4u hw = __builtin_nontemporal_load((const v4u*)((const bf16*)(AWS + WS_HB) + (size_t)t * DM + tid2 * 8));
        int iacc[64];
#pragma unroll
        for (int i = 0; i < 64; ++i) iacc[i] = 0;
#pragma unroll 1
        for (int k8 = 0; k8 < 2; ++k8) {
            const bool dn2 = false; const int esrc = (k8 < 1) ? eall : eall_n;
            P2_GROUP(b0, b1, b2, b3, 2 * k8, 0); P2_GROUP(b4, b5, b6, b7, 2 * k8 + 1, 4);
        }
        const int ioff2 = toff2_of(TB_U) * aqs; const float sa2 = 0.5f * sa;
#pragma unroll
        for (int c = 0; c < 4; ++c) {
#pragma unroll
            for (int q = 0; q < 4; ++q) *(LAS f32x4*)(part + wave * 4096 + 4 * (lanev + 64 * (4 * c + q))) = (f32x4){(float)(2 * iacc[c * 16 + 4 * q] - ioff2) * sa2, (float)(2 * iacc[c * 16 + 4 * q + 1] - ioff2) * sa2, (float)(2 * iacc[c * 16 + 4 * q + 2] - ioff2) * sa2, (float)(2 * iacc[c * 16 + 4 * q + 3] - ioff2) * sa2}; }
        __syncthreads();
        f32x4 v0 = (f32x4){bflo(hw.x), bfhi(hw.x), bflo(hw.y), bfhi(hw.y)}, v1 = (f32x4){bflo(hw.z), bfhi(hw.z), bflo(hw.w), bfhi(hw.w)};
#pragma unroll
        for (int w = 0; w < 8; ++w) { v0 += *(const LAS f32x4*)(part + w * 4096 + tid2 * 8); v1 += *(const LAS f32x4*)(part + w * 4096 + tid2 * 8 + 4); }
        float ss = (v0.x * v0.x + v0.y * v0.y) + (v0.z * v0.z + v0.w * v0.w) + (v1.x * v1.x + v1.y * v1.y) + (v1.z * v1.z + v1.w * v1.w);
        ss = wave_sum(ss);
        if (lanev == 0) red[wave] = ss;
        __syncthreads();
        float tot = 0.f;
#pragma unroll
        for (int w = 0; w < 8; ++w) tot += red[w];
        const float rstd = 1.0f / sqrtf(tot * (1.0f / DM) + EPS);
        const f32x4 g0 = *(const f32x4*)(AIN(I_GFIN) + tid2 * 8), g1 = *(const f32x4*)(AIN(I_GFIN) + tid2 * 8 + 4);
        int tid3 = tid; asm volatile("" : "+v"(tid3));
        float* orow = AOUT + (size_t)t * DM + tid3 * 8;
        __builtin_nontemporal_store(v0 * rstd * g0, (f32x4*)orow); __builtin_nontemporal_store(v1 * rstd * g1, (f32x4*)(orow + 4));
        eall = eall_n;
    }
    }
}

constexpr int PGW_X = 0, PGW_H = 32768, PGW_A = 98304, PGW_P = 102400;
__device__ __forceinline__ int pick_e(int lo, int hi, int idx) { const int p_ = __builtin_amdgcn_readlane(lo, idx & 63), q_ = __builtin_amdgcn_readlane(hi, idx & 63); return (idx & 64) ? q_ : p_; }
__device__ __forceinline__ void phase_gather_w(const Args& a, LAS unsigned char* lds, int tid, int lane, int wave) {
    constexpr bool LO = false;
    const unsigned char* XQ = AWS + WS_XQ; const unsigned char* DOWN = AWS + WS_DOWN; const unsigned char* UP = AWS + WS_UP;
    const float* SDN = (const float*)(AWS + WS_SDN); const float* SUP = (const float*)(AWS + WS_SUP); const float* XS = (const float*)(AWS + WS_XS); const int* XSUM = (const int*)(AWS + WS_XSUM);
    const int* IDX = (const int*)(AWS + WS_IDX); const float* GATE = (const float*)(AWS + WS_GATE);
#ifndef PGW_NW
#define PGW_NW NWAVES
#endif
    if (wave >= PGW_NW) return;
    const int ngw = gridDim.x * PGW_NW; int t = blockIdx.x * PGW_NW + wave; if (t >= T_TOK) return;
    LAS float* actl = (LAS float*)(lds + PGW_A + wave * 512); LAS float* prm = (LAS float*)(lds + PGW_P + wave * 2048);
    const int xoff = PGW_X + wave * 4096 + lane * 16, hoff = PGW_H + wave * 8192 + lane * 8;
    int elo = IDX[(size_t)t * 128 + lane], ehi = IDX[(size_t)t * 128 + 64 + lane];
    RowBuf b0, b1, b2, b3, b4, b5, b6, b7;
    { ROW_LOAD_B(TB_D, b0, DOWN, __builtin_amdgcn_readlane(elo, 0)); ROW_LOAD_B(TB_D, b1, DOWN, __builtin_amdgcn_readlane(elo, 1)); ROW_LOAD_B(TB_D, b2, DOWN, __builtin_amdgcn_readlane(elo, 2)); ROW_LOAD_B(TB_D, b3, DOWN, __builtin_amdgcn_readlane(elo, 3));
      ROW_LOAD_B(TB_D, b4, DOWN, __builtin_amdgcn_readlane(elo, 4)); ROW_LOAD_B(TB_D, b5, DOWN, __builtin_amdgcn_readlane(elo, 5)); ROW_LOAD_B(TB_D, b6, DOWN, __builtin_amdgcn_readlane(elo, 6)); ROW_LOAD_B(TB_D, b7, DOWN, __builtin_amdgcn_readlane(elo, 7)); }
    { const float xs = XS[t]; prm[lane] = SDN[elo] * xs; prm[64 + lane] = SDN[ehi] * xs; prm[128 + lane] = GATE[(size_t)t * 128 + lane] * SUP[elo]; prm[192 + lane] = GATE[(size_t)t * 128 + 64 + lane] * SUP[ehi];
#pragma unroll
      for (int c = 0; c < 4; ++c) *(LAS v4u*)(lds + xoff + c * 1024) = ((const v4u*)(XQ + (size_t)t * DM))[c * 64 + lane]; }
    int xsum = XSUM[t], par = 0;
    const bool h5 = lane & 32, h4 = lane & 16;
#define W1_STEP(B, J, DP) do { int idot = 0; { int xo_ = xoff; asm volatile("" : "+v"(xo_)); P1_CHUNK(B, 0); P1_CHUNK(B, 1); P1_CHUNK(B, 2); P1_CHUNK(B, 3); } \
        DP = idot; \
        { const int e_ = pick_e(elo, ehi, 8 * i + 8 + (J)); ROW_LOAD_SEL(B, dn1, e_); } PG_SB; } while (0)
#define W1_REDUCE(d0, d1, d2, d3, H) do {   \
        const int s0_ = h5 ? d0 : d2, k0_ = h5 ? d2 : d0, s1_ = h5 ? d1 : d3, k1_ = h5 ? d3 : d1; \
        const int w0_ = k0_ + __shfl_xor(s0_, 32), w1_ = k1_ + __shfl_xor(s1_, 32); \
        int y_ = (h4 ? w1_ : w0_) + __shfl_xor(h4 ? w0_ : w1_, 16); \
        y_ += __shfl_xor(y_, 8); y_ += __shfl_xor(y_, 4); y_ += __shfl_xor(y_, 2); y_ += __shfl_xor(y_, 1); \
        const int ej_ = 8 * i + 4 * (H) + (lanev >> 4); \
        const float dotv_ = (float)(2 * y_ - toff2_of(TB_D) * xsum) * 0.5f * pc[ej_];        \
        const float av_ = pg8::gelu_t(dotv_) * pc[128 + ej_]; \
        if ((lanev & 15) == 0) actl[ej_] = av_; } while (0)
#define W1_ITER() do { const bool dn1 = i < 15; int d0, d1, d2, d3, d4, d5, d6, d7; \
        W1_STEP(b0, 0, d0); W1_STEP(b1, 1, d1); W1_STEP(b2, 2, d2); W1_STEP(b3, 3, d3); W1_STEP(b4, 4, d4); W1_STEP(b5, 5, d5); W1_STEP(b6, 6, d6); W1_STEP(b7, 7, d7); \
        W1_REDUCE(d0, d1, d2, d3, 0); W1_REDUCE(d4, d5, d6, d7, 1); } while (0)
#define W2_GROUP(BA, BB, BC, BD, G, JB) do { const int a4 = pick_e(a4lo, a4hi, 4 * (G)); \
        P2_C4(BA, BB, BC, BD, 0); PG_SB; P2_C4(BA, BB, BC, BD, 1); PG_SB; P2_C4(BA, BB, BC, BD, 2); PG_SB; P2_C4(BA, BB, BC, BD, 3); PG_SB; \
        { const int e_ = pick_e(esl, esh, (8 * i + 8 + (JB)) & 127); ROW_LOAD_SEL(BA, dn2, e_); } { const int e_ = pick_e(esl, esh, (8 * i + 9 + (JB)) & 127); ROW_LOAD_SEL(BB, dn2, e_); } \
        { const int e_ = pick_e(esl, esh, (8 * i + 10 + (JB)) & 127); ROW_LOAD_SEL(BC, dn2, e_); } { const int e_ = pick_e(esl, esh, (8 * i + 11 + (JB)) & 127); ROW_LOAD_SEL(BD, dn2, e_); } } while (0)
    for (; t < T_TOK; t += ngw, par ^= 1) {
        const int tn = t + ngw; const size_t tq = (tn < T_TOK) ? (size_t)tn : (size_t)t;
        int lanev = lane; asm volatile("" : "+v"(lanev));
        const int elo_n = IDX[tq * 128 + lanev], ehi_n = IDX[tq * 128 + 64 + lanev]; const float glo_n = GATE[tq * 128 + lanev], ghi_n = GATE[tq * 128 + 64 + lanev];
        const float xs_n = XS[tq]; const int xsum_n = XSUM[tq];
        v4u xn[4]; v2u hb[16];
#pragma unroll
        for (int c = 0; c < 4; ++c) xn[c] = ((const v4u*)(XQ + tq * DM))[c * 64 + lanev];
#pragma unroll
        for (int k = 0; k < 16; ++k) hb[k] = ((const v2u*)((const bf16*)(AWS + WS_HB) + (size_t)t * DM))[k * 64 + lanev];
        const LAS float* pc = prm + par * 256;
#pragma unroll 1
        for (int i = 0; i < 8; ++i) W1_ITER();
        const float sdl = SDN[elo_n], sdh = SDN[ehi_n], sul = SUP[elo_n], suh = SUP[ehi_n];
#pragma unroll 1
        for (int i = 8; i < 16; ++i) W1_ITER();
#pragma unroll
        for (int c = 0; c < 4; ++c) *(LAS v4u*)(lds + xoff + c * 1024) = xn[c];
#pragma unroll
        for (int k = 0; k < 16; ++k) *(LAS v2u*)(lds + hoff + k * 512) = hb[k];
        { LAS float* pn = prm + (par ^ 1) * 256; pn[lanev] = sdl * xs_n; pn[64 + lanev] = sdh * xs_n; pn[128 + lanev] = glo_n * sul; pn[192 + lanev] = ghi_n * suh; }
        xsum = xsum_n;
        const float alo = actl[lanev], ahi = actl[64 + lanev];
        const float amax = wave_max(fmaxf(fabsf(alo), fabsf(ahi))); const float sa = amax * (1.0f / 127.0f), ainv = amax > 0.f ? 127.0f / amax : 0.f;
        const int aql = (int)rintf(alo * ainv), aqh = (int)rintf(ahi * ainv);
        int aqs = aql + aqh;
#pragma unroll
        for (int o = 1; o < 64; o <<= 1) aqs += __shfl_xor(aqs, o);
        const int bl_ = aql & 255, bh_ = aqh & 255;
        const int a4lo = bl_ | (__shfl_down(bl_, 1) << 8) | (__shfl_down(bl_, 2) << 16) | (__shfl_down(bl_, 3) << 24), a4hi = bh_ | (__shfl_down(bh_, 1) << 8) | (__shfl_down(bh_, 2) << 16) | (__shfl_down(bh_, 3) << 24);
        int iacc[64];
#pragma unroll
        for (int k = 0; k < 64; ++k) iacc[k] = 0;
#pragma unroll 1
        for (int i = 0; i < 16; ++i) {
            const bool dn2 = !(i < 15); const int esl = dn2 ? elo_n : elo, esh = dn2 ? ehi_n : ehi;
            W2_GROUP(b0, b1, b2, b3, 2 * i, 0); W2_GROUP(b4, b5, b6, b7, 2 * i + 1, 4);
        }
        const int ioff2 = toff2_of(TB_U) * aqs; const float sa2 = 0.5f * sa; float ss = 0.f;
#pragma unroll
        for (int k = 0; k < 16; ++k) { const v2u hv = *(const LAS v2u*)(lds + hoff + k * 512);
            const float v0 = (float)(2 * iacc[4 * k] - ioff2) * sa2 + bflo(hv.x), v1 = (float)(2 * iacc[4 * k + 1] - ioff2) * sa2 + bfhi(hv.x), v2 = (float)(2 * iacc[4 * k + 2] - ioff2) * sa2 + bflo(hv.y), v3 = (float)(2 * iacc[4 * k + 3] - ioff2) * sa2 + bfhi(hv.y);
            ss += (v0 * v0 + v1 * v1) + (v2 * v2 + v3 * v3);
            iacc[4 * k] = __float_as_int(v0); iacc[4 * k + 1] = __float_as_int(v1); iacc[4 * k + 2] = __float_as_int(v2); iacc[4 * k + 3] = __float_as_int(v3); }
        const float rstd = 1.0f / sqrtf(wave_sum(ss) * (1.0f / DM) + EPS);
        int lane3 = lane; asm volatile("" : "+v"(lane3));
        float* orow = AOUT + (size_t)t * DM + 4 * lane3; const float* gfin = AIN(I_GFIN) + 4 * lane3;
#pragma unroll
        for (int k = 0; k < 16; ++k) { const f32x4 g = *(const f32x4*)(gfin + 256 * k);
            *(f32x4*)(orow + 256 * k) = (f32x4){__int_as_float(iacc[4 * k]) * rstd * g.x, __int_as_float(iacc[4 * k + 1]) * rstd * g.y, __int_as_float(iacc[4 * k + 2]) * rstd * g.z, __int_as_float(iacc[4 * k + 3]) * rstd * g.w}; }
        elo = elo_n; ehi = ehi_n;
    }
}

constexpr int PWS_X = 0, PWS_P = 32768, PWS_A = 49152;
__device__ __forceinline__ void phase_gather_ws(const Args& a, LAS unsigned char* lds, int tid, int lane, int wave) {
    constexpr bool LO = false;
    const unsigned char* XQ = AWS + WS_XQ; const unsigned char* DOWN = AWS + WS_DOWN; const unsigned char* UP = AWS + WS_UP;
    const float* SDN = (const float*)(AWS + WS_SDN); const float* SUP = (const float*)(AWS + WS_SUP); const float* XS = (const float*)(AWS + WS_XS); const int* XSUM = (const int*)(AWS + WS_XSUM);
    const int* IDX = (const int*)(AWS + WS_IDX); const float* GATE = (const float*)(AWS + WS_GATE);
    const int ngw = gridDim.x * NWAVES, t0 = blockIdx.x * NWAVES + wave; if (t0 >= T_TOK) return;
    LAS float* actb = (LAS float*)(lds + PWS_A + wave * 4096); LAS float* prm = (LAS float*)(lds + PWS_P + wave * 2048);
    const int xoff = PWS_X + wave * 4096 + lane * 16;
    const bool h5 = lane & 32, h4 = lane & 16, lodd = lane & 1; (void)lodd;
    RowBuf b0, b1, b2, b3, b4, b5, b6, b7;
#define WS1_STEP(B, J, DP) do { int idot = 0; { int xo_ = xoff; asm volatile("" : "+v"(xo_)); P1_CHUNK(B, 0); P1_CHUNK(B, 1); P1_CHUNK(B, 2); P1_CHUNK(B, 3); } \
        DP = idot; \
        { const int e_ = pick_e(esl, esh, (8 * i + 8 + (J)) & 127); ROW_LOAD_B(TB_D, B, DOWN, e_); } PG_SB; } while (0)
#define WS1_ITER() do { const bool nx_ = !(i < 15); const int esl = nx_ ? elo_n : elo, esh = nx_ ? ehi_n : ehi; int d0, d1, d2, d3, d4, d5, d6, d7; \
        WS1_STEP(b0, 0, d0); WS1_STEP(b1, 1, d1); WS1_STEP(b2, 2, d2); WS1_STEP(b3, 3, d3); WS1_STEP(b4, 4, d4); WS1_STEP(b5, 5, d5); WS1_STEP(b6, 6, d6); WS1_STEP(b7, 7, d7); \
        W1_REDUCE(d0, d1, d2, d3, 0); W1_REDUCE(d4, d5, d6, d7, 1); } while (0)
    {
    int t = t0, par = 0, k = 0;
    int elo = IDX[(size_t)t * 128 + lane], ehi = IDX[(size_t)t * 128 + 64 + lane];
    { ROW_LOAD_B(TB_D, b0, DOWN, __builtin_amdgcn_readlane(elo, 0)); ROW_LOAD_B(TB_D, b1, DOWN, __builtin_amdgcn_readlane(elo, 1)); ROW_LOAD_B(TB_D, b2, DOWN, __builtin_amdgcn_readlane(elo, 2)); ROW_LOAD_B(TB_D, b3, DOWN, __builtin_amdgcn_readlane(elo, 3));
      ROW_LOAD_B(TB_D, b4, DOWN, __builtin_amdgcn_readlane(elo, 4)); ROW_LOAD_B(TB_D, b5, DOWN, __builtin_amdgcn_readlane(elo, 5)); ROW_LOAD_B(TB_D, b6, DOWN, __builtin_amdgcn_readlane(elo, 6)); ROW_LOAD_B(TB_D, b7, DOWN, __builtin_amdgcn_readlane(elo, 7)); }
    { const float xs = XS[t]; prm[lane] = SDN[elo] * xs; prm[64 + lane] = SDN[ehi] * xs; prm[128 + lane] = GATE[(size_t)t * 128 + lane] * SUP[elo]; prm[192 + lane] = GATE[(size_t)t * 128 + 64 + lane] * SUP[ehi];
#pragma unroll
      for (int c = 0; c < 4; ++c) *(LAS v4u*)(lds + xoff + c * 1024) = ((const v4u*)(XQ + (size_t)t * DM))[c * 64 + lane]; }
    int xsum = XSUM[t];
    for (; t < T_TOK; t += ngw, par ^= 1, ++k) {
        const int tn = t + ngw; const size_t tq = (tn < T_TOK) ? (size_t)tn : (size_t)t;
        int lanev = lane; asm volatile("" : "+v"(lanev));
        const int elo_n = IDX[tq * 128 + lanev], ehi_n = IDX[tq * 128 + 64 + lanev]; const float glo_n = GATE[tq * 128 + lanev], ghi_n = GATE[tq * 128 + 64 + lanev];
        const float xs_n = XS[tq]; const int xsum_n = XSUM[tq];
        v4u xn[4];
#pragma unroll
        for (int c = 0; c < 4; ++c) xn[c] = ((const v4u*)(XQ + tq * DM))[c * 64 + lanev];
        const LAS float* pc = prm + par * 256; LAS float* actl = actb + (k & 7) * 128;
#pragma unroll 1
        for (int i = 0; i < 8; ++i) WS1_ITER();
        const float sdl = SDN[elo_n], sdh = SDN[ehi_n], sul = SUP[elo_n], suh = SUP[ehi_n];
#pragma unroll 1
        for (int i = 8; i < 16; ++i) WS1_ITER();
#pragma unroll
        for (int c = 0; c < 4; ++c) *(LAS v4u*)(lds + xoff + c * 1024) = xn[c];
        { LAS float* pn = prm + (par ^ 1) * 256; pn[lanev] = sdl * xs_n; pn[64 + lanev] = sdh * xs_n; pn[128 + lanev] = glo_n * sul; pn[192 + lanev] = ghi_n * suh; }
        xsum = xsum_n; elo = elo_n; ehi = ehi_n;
    }
    }
    {
    int t = t0, k = 0;
    int elo = IDX[(size_t)t * 128 + lane], ehi = IDX[(size_t)t * 128 + 64 + lane];
    { ROW_LOAD_B(TB_U, b0, UP, __builtin_amdgcn_readlane(elo, 0)); ROW_LOAD_B(TB_U, b1, UP, __builtin_amdgcn_readlane(elo, 1)); ROW_LOAD_B(TB_U, b2, UP, __builtin_amdgcn_readlane(elo, 2)); ROW_LOAD_B(TB_U, b3, UP, __builtin_amdgcn_readlane(elo, 3));
      ROW_LOAD_B(TB_U, b4, UP, __builtin_amdgcn_readlane(elo, 4)); ROW_LOAD_B(TB_U, b5, UP, __builtin_amdgcn_readlane(elo, 5)); ROW_LOAD_B(TB_U, b6, UP, __builtin_amdgcn_readlane(elo, 6)); ROW_LOAD_B(TB_U, b7, UP, __builtin_amdgcn_readlane(elo, 7)); }
    for (; t < T_TOK; t += ngw, ++k) {
        const int tn = t + ngw; const size_t tq = (tn < T_TOK) ? (size_t)tn : (size_t)t;
        int lanev = lane; asm volatile("" : "+v"(lanev));
        const int elo_n = IDX[tq * 128 + lanev], ehi_n = IDX[tq * 128 + 64 + lanev];
        const float alo = actb[(k & 7) * 128 + lanev], ahi = actb[(k & 7) * 128 + 64 + lanev];
        const float amax = wave_max(fmaxf(fabsf(alo), fabsf(ahi))); const float sa = amax * (1.0f / 127.0f), ainv = amax > 0.f ? 127.0f / amax : 0.f;
        const int aql = (int)rintf(alo * ainv), aqh = (int)rintf(ahi * ainv);
        int aqs = aql + aqh;
#pragma unroll
        for (int o = 1; o < 64; o <<= 1) aqs += __shfl_xor(aqs, o);
        const int bl_ = aql & 255, bh_ = aqh & 255;
        const int a4lo = bl_ | (__shfl_down(bl_, 1) << 8) | (__shfl_down(bl_, 2) << 16) | (__shfl_down(bl_, 3) << 24), a4hi = bh_ | (__shfl_down(bh_, 1) << 8) | (__shfl_down(bh_, 2) << 16) | (__shfl_down(bh_, 3) << 24);
        int iacc[64];
#pragma unroll
        for (int q = 0; q < 64; ++q) iacc[q] = 0;
#pragma unroll 1
        for (int i = 0; i < 16; ++i) {
            const bool dn2 = false, nx_ = !(i < 15); const int esl = nx_ ? elo_n : elo, esh = nx_ ? ehi_n : ehi;
            W2_GROUP(b0, b1, b2, b3, 2 * i, 0); W2_GROUP(b4, b5, b6, b7, 2 * i + 1, 4);
        }
        const int ioff2 = toff2_of(TB_U) * aqs; const float sa2 = 0.5f * sa; float ss = 0.f;
        int lane3 = lane; asm volatile("" : "+v"(lane3));
        const v2u* hbr = (const v2u*)((const bf16*)(AWS + WS_HB) + (size_t)t * DM) + lane3; v2u hb[16];
#pragma unroll
        for (int q = 0; q < 16; ++q) hb[q] = __builtin_nontemporal_load(hbr + 64 * q);
#pragma unroll
        for (int q = 0; q < 16; ++q) { const v2u hv = hb[q];
            const float v0 = (float)(2 * iacc[4 * q] - ioff2) * sa2 + bflo(hv.x), v1 = (float)(2 * iacc[4 * q + 1] - ioff2) * sa2 + bfhi(hv.x), v2 = (float)(2 * iacc[4 * q + 2] - ioff2) * sa2 + bflo(hv.y), v3 = (float)(2 * iacc[4 * q + 3] - ioff2) * sa2 + bfhi(hv.y);
            ss += (v0 * v0 + v1 * v1) + (v2 * v2 + v3 * v3);
            iacc[4 * q] = __float_as_int(v0); iacc[4 * q + 1] = __float_as_int(v1); iacc[4 * q + 2] = __float_as_int(v2); iacc[4 * q + 3] = __float_as_int(v3); }
        const float rstd = 1.0f / sqrtf(wave_sum(ss) * (1.0f / DM) + EPS);
        float* orow = AOUT + (size_t)t * DM + 4 * lane3; const float* gfin = AIN(I_GFIN) + 4 * lane3;
#pragma unroll
        for (int q = 0; q < 16; ++q) { const f32x4 g = *(const f32x4*)(gfin + 256 * q);
            __builtin_nontemporal_store((f32x4){__int_as_float(iacc[4 * q]) * rstd * g.x, __int_as_float(iacc[4 * q + 1]) * rstd * g.y, __int_as_float(iacc[4 * q + 2]) * rstd * g.z, __int_as_float(iacc[4 * q + 3]) * rstd * g.w}, (f32x4*)(orow + 256 * q)); }
        elo = elo_n; ehi = ehi_n;
    }
    }
}

constexpr int WD_CTR = 8192;
template <int PASS, bool DYN = true> __device__ __forceinline__ void phase_gather_wd(const Args& a, LAS unsigned char* lds, int tid, int lane, int wave) {
    constexpr bool LO = false;
    const unsigned char* XQ = AWS + WS_XQ; const unsigned char* DOWN = AWS + WS_DOWN; const unsigned char* UP = AWS + WS_UP;
    const float* SDN = (const float*)(AWS + WS_SDN); const float* SUP = (const float*)(AWS + WS_SUP); const float* XS = (const float*)(AWS + WS_XS); const int* XSUM = (const int*)(AWS + WS_XSUM);
    const int* IDX = (const int*)(AWS + WS_IDX); const float* GATE = (const float*)(AWS + WS_GATE); float* ACT = (float*)(AWS + WS_STV);
    unsigned* ctr = (unsigned*)(AWS + WS_CTL) + WD_CTR + (PASS - 1) * 64;
    const int ngw = gridDim.x * NWAVES, t0 = blockIdx.x * NWAVES + wave; if (t0 >= T_TOK) return;
    LAS float* prm = (LAS float*)(lds + PWS_P + wave * 2048);
    const int xoff = PWS_X + wave * 4096 + lane * 16;
    const bool h5 = lane & 32, h4 = lane & 16, lodd = lane & 1; (void)lodd; (void)h5; (void)h4;
    RowBuf b0, b1, b2, b3, b4, b5, b6, b7;
    int t = t0;
    int tn; if (DYN) { unsigned g_ = 0u; if (lane == 0) g_ = atomicAdd(ctr, 1u); tn = ngw + __builtin_amdgcn_readfirstlane((int)g_); } else tn = t + ngw;
    if constexpr (PASS == 1) {
#define WD1_REDUCE(d0, d1, d2, d3, H) do { \
        const int s0_ = h5 ? d0 : d2, k0_ = h5 ? d2 : d0, s1_ = h5 ? d1 : d3, k1_ = h5 ? d3 : d1; \
        const int w0_ = k0_ + __shfl_xor(s0_, 32), w1_ = k1_ + __shfl_xor(s1_, 32); \
        int y_ = (h4 ? w1_ : w0_) + __shfl_xor(h4 ? w0_ : w1_, 16); \
        y_ += __shfl_xor(y_, 8); y_ += __shfl_xor(y_, 4); y_ += __shfl_xor(y_, 2); y_ += __shfl_xor(y_, 1); \
        const int ej_ = 8 * i + 4 * (H) + (lanev >> 4); \
        const float dotv_ = (float)(2 * y_ - toff2_of(TB_D) * xsum) * 0.5f * pc[ej_]; \
        const float av_ = pg8::gelu_t(dotv_) * pc[128 + ej_]; \
        if ((lanev & 15) == 0) actg[ej_] = av_; } while (0)
#define WD1_ITER() do { const bool nx_ = !(i < 15); const int esl = nx_ ? elo_n : elo, esh = nx_ ? ehi_n : ehi; int d0, d1, d2, d3, d4, d5, d6, d7; \
        WS1_STEP(b0, 0, d0); WS1_STEP(b1, 1, d1); WS1_STEP(b2, 2, d2); WS1_STEP(b3, 3, d3); WS1_STEP(b4, 4, d4); WS1_STEP(b5, 5, d5); WS1_STEP(b6, 6, d6); WS1_STEP(b7, 7, d7); \
        WD1_REDUCE(d0, d1, d2, d3, 0); WD1_REDUCE(d4, d5, d6, d7, 1); } while (0)
    int par = 0;
    int elo = IDX[(size_t)t * 128 + lane], ehi = IDX[(size_t)t * 128 + 64 + lane];
    { ROW_LOAD_B(TB_D, b0, DOWN, __builtin_amdgcn_readlane(elo, 0)); ROW_LOAD_B(TB_D, b1, DOWN, __builtin_amdgcn_readlane(elo, 1)); ROW_LOAD_B(TB_D, b2, DOWN, __builtin_amdgcn_readlane(elo, 2)); ROW_LOAD_B(TB_D, b3, DOWN, __builtin_amdgcn_readlane(elo, 3));
      ROW_LOAD_B(TB_D, b4, DOWN, __builtin_amdgcn_readlane(elo, 4)); ROW_LOAD_B(TB_D, b5, DOWN, __builtin_amdgcn_readlane(elo, 5)); ROW_LOAD_B(TB_D, b6, DOWN, __builtin_amdgcn_readlane(elo, 6)); ROW_LOAD_B(TB_D, b7, DOWN, __builtin_amdgcn_readlane(elo, 7)); }
    { const float xs = XS[t]; prm[lane] = SDN[elo] * xs; prm[64 + lane] = SDN[ehi] * xs; prm[128 + lane] = GATE[(size_t)t * 128 + lane] * SUP[elo]; prm[192 + lane] = GATE[(size_t)t * 128 + 64 + lane] * SUP[ehi];
#pragma unroll
      for (int c = 0; c < 4; ++c) *(LAS v4u*)(lds + xoff + c * 1024) = ((const v4u*)(XQ + (size_t)t * DM))[c * 64 + lane]; }
    int xsum = XSUM[t];
    for (; t < T_TOK; par ^= 1) {
        unsigned g_ = 0u; if (lane == 0) g_ = atomicAdd(ctr, 1u);
        const size_t tq = (tn < T_TOK) ? (size_t)tn : (size_t)t;
        int lanev = lane; asm volatile("" : "+v"(lanev));
        const int elo_n = IDX[tq * 128 + lanev], ehi_n = IDX[tq * 128 + 64 + lanev]; const float glo_n = GATE[tq * 128 + lanev], ghi_n = GATE[tq * 128 + 64 + lanev];
        const float xs_n = XS[tq]; const int xsum_n = XSUM[tq];
        v4u xn[4];
#pragma unroll
        for (int c = 0; c < 4; ++c) xn[c] = ((const v4u*)(XQ + tq * DM))[c * 64 + lanev];
        const LAS float* pc = prm + par * 256; float* actg = ACT + (size_t)t * 128;
#pragma unroll 1
        for (int i = 0; i < 8; ++i) WD1_ITER();
        const float sdl = SDN[elo_n], sdh = SDN[ehi_n], sul = SUP[elo_n], suh = SUP[ehi_n];
#pragma unroll 1
        for (int i = 8; i < 16; ++i) WD1_ITER();
#pragma unroll
        for (int c = 0; c < 4; ++c) *(LAS v4u*)(lds + xoff + c * 1024) = xn[c];
        { LAS float* pn = prm + (par ^ 1) * 256; pn[lanev] = sdl * xs_n; pn[64 + lanev] = sdh * xs_n; pn[128 + lanev] = glo_n * sul; pn[192 + lanev] = ghi_n * suh; }
        xsum = xsum_n; elo = elo_n; ehi = ehi_n;
        t = tn; tn = ngw + __builtin_amdgcn_readfirstlane((int)g_);
    }
    } else {
    int elo = IDX[(size_t)t * 128 + lane], ehi = IDX[(size_t)t * 128 + 64 + lane];
    { ROW_LOAD_B(TB_U, b0, UP, __builtin_amdgcn_readlane(elo, 0)); ROW_LOAD_B(TB_U, b1, UP, __builtin_amdgcn_readlane(elo, 1)); ROW_LOAD_B(TB_U, b2, UP, __builtin_amdgcn_readlane(elo, 2)); ROW_LOAD_B(TB_U, b3, UP, __builtin_amdgcn_readlane(elo, 3));
      ROW_LOAD_B(TB_U, b4, UP, __builtin_amdgcn_readlane(elo, 4)); ROW_LOAD_B(TB_U, b5, UP, __builtin_amdgcn_readlane(elo, 5)); ROW_LOAD_B(TB_U, b6, UP, __builtin_amdgcn_readlane(elo, 6)); ROW_LOAD_B(TB_U, b7, UP, __builtin_amdgcn_readlane(elo, 7)); }
    float alo = ACT[(size_t)t * 128 + lane], ahi = ACT[(size_t)t * 128 + 64 + lane];
    for (; t < T_TOK;) {
        unsigned g_ = 0u; if (DYN) { if (lane == 0) g_ = atomicAdd(ctr, 1u); }
        const size_t tq = (tn < T_TOK) ? (size_t)tn : (size_t)t;
        int lanev = lane; asm volatile("" : "+v"(lanev));
        const int elo_n = IDX[tq * 128 + lanev], ehi_n = IDX[tq * 128 + 64 + lanev];
        const float alo_n = ACT[tq * 128 + lanev], ahi_n = ACT[tq * 128 + 64 + lanev];
        const float amax = wave_max(fmaxf(fabsf(alo), fabsf(ahi))); const float sa = amax * (1.0f / 127.0f), ainv = amax > 0.f ? 127.0f / amax : 0.f;
        const int aql = (int)rintf(alo * ainv), aqh = (int)rintf(ahi * ainv);
        int aqs = aql + aqh;
#pragma unroll
        for (int o = 1; o < 64; o <<= 1) aqs += __shfl_xor(aqs, o);
        const int bl_ = aql & 255, bh_ = aqh & 255;
        const int a4lo = bl_ | (__shfl_down(bl_, 1) << 8) | (__shfl_down(bl_, 2) << 16) | (__shfl_down(bl_, 3) << 24), a4hi = bh_ | (__shfl_down(bh_, 1) << 8) | (__shfl_down(bh_, 2) << 16) | (__shfl_down(bh_, 3) << 24);
        int iacc[64];
#pragma unroll
        for (int q = 0; q < 64; ++q) iacc[q] = 0;
#pragma unroll 1
        for (int i = 0; i < 16; ++i) {
            const bool dn2 = false, nx_ = !(i < 15); const int esl = nx_ ? elo_n : elo, esh = nx_ ? ehi_n : ehi;
            W2_GROUP(b0, b1, b2, b3, 2 * i, 0); W2_GROUP(b4, b5, b6, b7, 2 * i + 1, 4);
        }
        const int ioff2 = toff2_of(TB_U) * aqs; const float sa2 = 0.5f * sa; float ss = 0.f;
        int lane3 = lane; asm volatile("" : "+v"(lane3));
        const v2u* hbr = (const v2u*)((const bf16*)(AWS + WS_HB) + (size_t)t * DM) + lane3; v2u hb[16];
#pragma unroll
        for (int q = 0; q < 16; ++q) hb[q] = __builtin_nontemporal_load(hbr + 64 * q);
#pragma unroll
        for (int q = 0; q < 16; ++q) { const v2u hv = hb[q];
            const float v0 = (float)(2 * iacc[4 * q] - ioff2) * sa2 + bflo(hv.x), v1 = (float)(2 * iacc[4 * q + 1] - ioff2) * sa2 + bfhi(hv.x), v2 = (float)(2 * iacc[4 * q + 2] - ioff2) * sa2 + bflo(hv.y), v3 = (float)(2 * iacc[4 * q + 3] - ioff2) * sa2 + bfhi(hv.y);
            ss += (v0 * v0 + v1 * v1) + (v2 * v2 + v3 * v3);
            iacc[4 * q] = __float_as_int(v0); iacc[4 * q + 1] = __float_as_int(v1); iacc[4 * q + 2] = __float_as_int(v2); iacc[4 * q + 3] = __float_as_int(v3); }
        const float rstd = 1.0f / sqrtf(wave_sum(ss) * (1.0f / DM) + EPS);
        float* orow = AOUT + (size_t)t * DM + 4 * lane3; const float* gfin = AIN(I_GFIN) + 4 * lane3;
#pragma unroll
        for (int q = 0; q < 16; ++q) { const f32x4 g = *(const f32x4*)(gfin + 256 * q);
            __builtin_nontemporal_store((f32x4){__int_as_float(iacc[4 * q]) * rstd * g.x, __int_as_float(iacc[4 * q + 1]) * rstd * g.y, __int_as_float(iacc[4 * q + 2]) * rstd * g.z, __int_as_float(iacc[4 * q + 3]) * rstd * g.w}, (f32x4*)(orow + 256 * q)); }
        elo = elo_n; ehi = ehi_n; alo = alo_n; ahi = ahi_n;
        { const int t_old = tn; t = tn; tn = DYN ? ngw + __builtin_amdgcn_readfirstlane((int)g_) : t_old + ngw; }
    }
    }
}

struct RowBufS { v4u n0, n1; float sd, su; };
constexpr int PSL_L = 32768;
__device__ __forceinline__ void phase_gather_p1s(const Args& a, LAS unsigned char* lds, int tid, int lane, int wave) {
    static_assert(TB_D == 4 && TB_U == 4 && DOWN_SGN, "sliced pass 1: 4-bit rows, signed-nibble down table");
    constexpr bool LO = false;
    const unsigned char* XQ = AWS + WS_XQ; const unsigned char* DOWN = AWS + WS_DOWN;
    const float* SDN = (const float*)(AWS + WS_SDN); const float* SUP = (const float*)(AWS + WS_SUP); const float* XS = (const float*)(AWS + WS_XS); const int* XSUM = (const int*)(AWS + WS_XSUM);
    const int* IDX = (const int*)(AWS + WS_IDX); const float* GATE = (const float*)(AWS + WS_GATE); float* ACT = (float*)(AWS + WS_STV);
    unsigned* ctrb = (unsigned*)(AWS + WS_CTL) + WD_CTR + 128;
    const int xoff = PWS_X + wave * 4096 + lane * 16;
    LAS int* lbase = (LAS int*)(lds + PSL_L + wave * 4096);
    const bool h5 = lane & 32, h4 = lane & 16;
    const int myslice = (int)((unsigned)__builtin_amdgcn_s_getreg((3 << 11) | 20) & 7u);
    int zv = 0; asm volatile("" : "+v"(zv));
    RowBufS b0, b1, b2, b3, b4, b5, b6, b7;
#define PS_LOAD(B, e) do { const int e__ = (e); const unsigned char* rb_ = DOWN + (size_t)e__ * 2048; B.n0 = ((const v4u*)rb_)[lane]; B.n1 = ((const v4u*)rb_)[64 + lane]; B.sd = SDN[e__ + zv]; B.su = SUP[e__ + zv]; } while (0)
#define PS_BUILD(sl, e0, e1, g0, g1, N, N8) do { LAS int* L_ = lbase + (sl) * 512; \
        const bool s0_ = ((e0) >> 11) == s, s1_ = ((e1) >> 11) == s; const unsigned long long m0_ = __ballot(s0_), m1_ = __ballot(s1_); \
        const int n0_ = __popcll(m0_); N = n0_ + __popcll(m1_); N8 = (N == 0) ? 8 : ((N + 7) & ~7); \
        const int p0_ = (int)__builtin_amdgcn_mbcnt_hi((unsigned)(m0_ >> 32), __builtin_amdgcn_mbcnt_lo((unsigned)m0_, 0u)), p1_ = n0_ + (int)__builtin_amdgcn_mbcnt_hi((unsigned)(m1_ >> 32), __builtin_amdgcn_mbcnt_lo((unsigned)m1_, 0u)); \
        if (lane < 8 && N + lane < N8) { L_[N + lane] = s * 2048; L_[128 + N + lane] = 0; } \
        if (s0_) { L_[p0_] = (e0); L_[128 + p0_] = lane; ((LAS float*)L_)[256 + p0_] = (g0); } \
        if (s1_) { L_[p1_] = (e1); L_[128 + p1_] = 64 + lane; ((LAS float*)L_)[256 + p1_] = (g1); } } while (0)
#define PS_CHUNK(B, C) do { if constexpr (LO) { ia_ ^= (int)(B.n0[C] ^ B.n1[C]); } else { const v4u xv_ = *(const LAS v4u*)(lds + xo_ + (C) * 1024); \
        ia_ = __builtin_amdgcn_sdot8((int)B.n0[C], (int)xv_.x, ia_, false); ib_ = __builtin_amdgcn_sdot8((int)B.n0[C], (int)xv_.y, ib_, false); ia_ = __builtin_amdgcn_sdot8((int)B.n1[C], (int)xv_.z, ia_, false); ib_ = __builtin_amdgcn_sdot8((int)B.n1[C], (int)xv_.w, ib_, false); } } while (0)
#define PS_STEP(B, J, DP, SD, SU) do { int ia_ = 0, ib_ = 0; { int xo_ = xoff; asm volatile("" : "+v"(xo_)); PS_CHUNK(B, 0); PS_CHUNK(B, 1); PS_CHUNK(B, 2); PS_CHUNK(B, 3); } \
        DP = 16 * ia_ + ib_; SD = B.sd; SU = B.su; \
        { const int e_ = pick_e(esl, esh, rbase + (J)); PS_LOAD(B, e_); } PG_SB; } while (0)
#define PS_REDUCE(d0, d1, d2, d3, sa0, sa1, sa2, sa3, ua0, ua1, ua2, ua3, H) do { \
        const int s0_ = h5 ? d0 : d2, k0_ = h5 ? d2 : d0, s1_ = h5 ? d1 : d3, k1_ = h5 ? d3 : d1; \
        const int w0_ = k0_ + __shfl_xor(s0_, 32), w1_ = k1_ + __shfl_xor(s1_, 32); \
        int y_ = (h4 ? w1_ : w0_) + __shfl_xor(h4 ? w0_ : w1_, 16); \
        y_ += __shfl_xor(y_, 8); y_ += __shfl_xor(y_, 4); y_ += __shfl_xor(y_, 2); y_ += __shfl_xor(y_, 1); \
        const int p_ = 8 * i + 4 * (H) + (lanev >> 4); \
        const float sd_ = h5 ? (h4 ? sa3 : sa2) : (h4 ? sa1 : sa0), su_ = h5 ? (h4 ? ua3 : ua2) : (h4 ? ua1 : ua0); \
        const float dotv_ = (float)(2 * y_ + xsum) * 0.5f * (sd_ * xs);        \
        const float av_ = pg8::gelu_t(dotv_) * ((const LAS float*)Lc)[256 + p_] * su_; \
        if ((lanev & 15) == 0 && p_ < n) __builtin_nontemporal_store(av_, ACT + (size_t)t * 128 + Lc[128 + p_]); } while (0)
#pragma unroll 1
    for (int ks = 0; ks < 8; ++ks) {
        const int s = (myslice + ks) & 7; unsigned* ctr = ctrb + s * 64;
        int t; { unsigned g_ = 0u; if (lane == 0) g_ = atomicAdd(ctr, 1u); t = __builtin_amdgcn_readfirstlane((int)g_); }
        if (t >= T_TOK) continue;
        int tn; { unsigned g_ = 0u; if (lane == 0) g_ = atomicAdd(ctr, 1u); tn = __builtin_amdgcn_readfirstlane((int)g_); }
        int cur = 0, n, n8;
        { const int e0 = IDX[(size_t)t * 128 + lane], e1 = IDX[(size_t)t * 128 + 64 + lane]; const float g0 = GATE[(size_t)t * 128 + lane], g1 = GATE[(size_t)t * 128 + 64 + lane];
          PS_BUILD(0, e0, e1, g0, g1, n, n8); }
        int llo = lbase[lane], lhi = lbase[64 + lane];
        { PS_LOAD(b0, __builtin_amdgcn_readlane(llo, 0)); PS_LOAD(b1, __builtin_amdgcn_readlane(llo, 1)); PS_LOAD(b2, __builtin_amdgcn_readlane(llo, 2)); PS_LOAD(b3, __builtin_amdgcn_readlane(llo, 3));
          PS_LOAD(b4, __builtin_amdgcn_readlane(llo, 4)); PS_LOAD(b5, __builtin_amdgcn_readlane(llo, 5)); PS_LOAD(b6, __builtin_amdgcn_readlane(llo, 6)); PS_LOAD(b7, __builtin_amdgcn_readlane(llo, 7)); }
#pragma unroll
        for (int c = 0; c < 4; ++c) *(LAS v4u*)(lds + xoff + c * 1024) = ((const v4u*)(XQ + (size_t)t * DM))[c * 64 + lane];
        int xsum = XSUM[t]; float xs = XS[t];
        for (;;) {
            unsigned g_ = 0u; if (lane == 0) g_ = atomicAdd(ctr, 1u);
            const bool hasn = tn < T_TOK; const size_t tq = hasn ? (size_t)tn : (size_t)t;
            int lanev = lane; asm volatile("" : "+v"(lanev));
            const int e0n = __builtin_nontemporal_load(IDX + tq * 128 + lanev), e1n = __builtin_nontemporal_load(IDX + tq * 128 + 64 + lanev); const float g0n = __builtin_nontemporal_load(GATE + tq * 128 + lanev), g1n = __builtin_nontemporal_load(GATE + tq * 128 + 64 + lanev);
            const float xs_n = XS[tq]; const int xsum_n = XSUM[tq];
            v4u xn[4];
#pragma unroll
            for (int c = 0; c < 4; ++c) xn[c] = __builtin_nontemporal_load((const v4u*)(XQ + tq * DM) + c * 64 + lanev);
            const LAS int* Lc = lbase + cur * 512; const int nit = n8 >> 3;
            int nn = 0, nn8 = 8, lnlo = 0, lnhi = 0;
#pragma unroll 1
            for (int i = 0; i < nit; ++i) {
                const bool lastit = (i == nit - 1);
                if (lastit) { PS_BUILD(cur ^ 1, e0n, e1n, g0n, g1n, nn, nn8); lnlo = lbase[(cur ^ 1) * 512 + lanev]; lnhi = lbase[(cur ^ 1) * 512 + 64 + lanev]; }
                const int esl = lastit ? lnlo : llo, esh = lastit ? lnhi : lhi, rbase = lastit ? 0 : 8 * i + 8;
                int d0, d1, d2, d3, d4, d5, d6, d7; float sd0, sd1, sd2, sd3, sd4, sd5, sd6, sd7, su0, su1, su2, su3, su4, su5, su6, su7;
                PS_STEP(b0, 0, d0, sd0, su0); PS_STEP(b1, 1, d1, sd1, su1); PS_STEP(b2, 2, d2, sd2, su2); PS_STEP(b3, 3, d3, sd3, su3);
                PS_STEP(b4, 4, d4, sd4, su4); PS_STEP(b5, 5, d5, sd5, su5); PS_STEP(b6, 6, d6, sd6, su6); PS_STEP(b7, 7, d7, sd7, su7);
                PS_REDUCE(d0, d1, d2, d3, sd0, sd1, sd2, sd3, su0, su1, su2, su3, 0); PS_REDUCE(d4, d5, d6, d7, sd4, sd5, sd6, sd7, su4, su5, su6, su7, 1);
            }
            if (!hasn) break;
#pragma unroll
            for (int c = 0; c < 4; ++c) *(LAS v4u*)(lds + xoff + c * 1024) = xn[c];
            xsum = xsum_n; xs = xs_n; n = nn; n8 = nn8; llo = lnlo; lhi = lnhi; cur ^= 1;
            t = tn; tn = __builtin_amdgcn_readfirstlane((int)g_);
        }
    }
}

constexpr int P1C_CTR = WD_CTR + 128 + 16 * 64;
__device__ __forceinline__ void phase_gather_p1c(const Args& a, LAS unsigned char* lds, int tid, int lane, int wave) {
    static_assert(TB_D == 4 && DOWN_SGN && DOWN_SLICED, "column-sliced pass 1: 4-bit signed-nibble slice-major down table");
    const unsigned char* DNS = AWS + WS_DOWN; const unsigned char* XQ = AWS + WS_XQ; const int* IDX = (const int*)(AWS + WS_IDX); int* ACTI = (int*)(AWS + WS_STV);
    unsigned* ctrb = (unsigned*)(AWS + WS_CTL) + P1C_CTR;
    const int g = lane >> 4, l16 = lane & 15;
    const bool b3 = lane & 8, b2 = lane & 4, b1 = lane & 2, b0_ = lane & 1;
    const int myslice = (int)((unsigned)__builtin_amdgcn_s_getreg((3 << 11) | 20) & 7u);
    LAS int* lidx0 = (LAS int*)(lds + wave * 4096);
#define D_LOAD(B, k) do { const unsigned o_ = (unsigned)lidx[(k)] + lo16; B = *(const v4u*)(dns + o_); } while (0)
#define D_STEP(B, J) do { int ac_ = 0; \
        _Pragma("unroll") for (int k = 0; k < 4; ++k) ac_ = __builtin_amdgcn_sdot8((int)B[k], (int)xh[k], ac_, false); \
        ac_ <<= 4; \
        _Pragma("unroll") for (int k = 0; k < 4; ++k) ac_ = __builtin_amdgcn_sdot8((int)B[k], (int)xl[k], ac_, false); \
        d[J] = ac_; \
        if (((J) & 3) == 0) idq = *(const LAS v4u*)(lq + (J));        \
        { const unsigned o_ = idq[(J) & 3] + lo16; B = *(const v4u*)(dns + o_); } } while (0)
#pragma unroll 1
    for (int ks = 0; ks < 8; ++ks) {
        const int s = (myslice + ks) & 7; unsigned* ctr = ctrb + s * 64;
        const unsigned char* dns = DNS + (size_t)s * NEXP * 256; const unsigned lo16 = 16u * (unsigned)l16;
        const size_t xo = ((size_t)(s >> 1) * 64 + 4 * l16) * 16 + (s & 1) * 8;
        int item, itemn; { unsigned g_ = 0u, h_ = 0u; if (lane == 0) { g_ = atomicAdd(ctr, 1u); h_ = atomicAdd(ctr, 1u); } item = __builtin_amdgcn_readfirstlane((int)g_); itemn = __builtin_amdgcn_readfirstlane((int)h_); }
        if (item >= T_TOK / 4) continue;
        int par = 0; v4u b0, b1_, b2_, b3_, b4, b5, b6, b7, b8, b9, b10, b11, b12, b13, b14, b15; unsigned xh[4], xl[4];
        { const int t_ = item * 4 + g;
#pragma unroll
          for (int j = 0; j < 8; ++j) lidx0[g * 128 + l16 + 16 * j] = IDX[(size_t)t_ * 128 + l16 + 16 * j] << 8;
#pragma unroll
          for (int k = 0; k < 4; ++k) { const v2u w = *(const v2u*)(XQ + (size_t)t_ * DM + xo + 16 * k); xh[k] = w.x; xl[k] = w.y; } }
        { LAS int* lidx = lidx0 + g * 128; D_LOAD(b0, 0); D_LOAD(b1_, 1); D_LOAD(b2_, 2); D_LOAD(b3_, 3); D_LOAD(b4, 4); D_LOAD(b5, 5); D_LOAD(b6, 6); D_LOAD(b7, 7);
          D_LOAD(b8, 8); D_LOAD(b9, 9); D_LOAD(b10, 10); D_LOAD(b11, 11); D_LOAD(b12, 12); D_LOAD(b13, 13); D_LOAD(b14, 14); D_LOAD(b15, 15); }
        for (;;) {
            unsigned g_ = 0u; if (lane == 0) g_ = atomicAdd(ctr, 1u);
            const bool hasn = itemn < T_TOK / 4; const int t = item * 4 + g, tn = (hasn ? itemn : item) * 4 + g;
            int lanev = lane; asm volatile("" : "+v"(lanev)); const int l16v = lanev & 15;
            int evn[8]; v2u xn[4];
#pragma unroll
            for (int j = 0; j < 8; ++j) evn[j] = IDX[(size_t)tn * 128 + l16v + 16 * j];
#pragma unroll
            for (int k = 0; k < 4; ++k) xn[k] = *(const v2u*)(XQ + (size_t)tn * DM + xo + 16 * k);
            LAS int* lidx = lidx0 + par * 512 + g * 128; int* actp = ACTI + (size_t)t * 128 + l16v;
            const LAS int* lidxn = lidx0 + (par ^ 1) * 512 + g * 128;
#pragma unroll 1
            for (int i = 0; i < 8; ++i) { int d[16]; v4u idq; const LAS int* lq = (i < 7) ? lidx + 16 * i + 16 : lidxn;
                if (i == 4) {
#pragma unroll
                    for (int j = 0; j < 8; ++j) lidx0[(par ^ 1) * 512 + g * 128 + l16v + 16 * j] = evn[j] << 8; }
                D_STEP(b0, 0); D_STEP(b1_, 1); D_STEP(b2_, 2); D_STEP(b3_, 3); D_STEP(b4, 4); D_STEP(b5, 5); D_STEP(b6, 6); D_STEP(b7, 7);
                D_STEP(b8, 8); D_STEP(b9, 9); D_STEP(b10, 10); D_STEP(b11, 11); D_STEP(b12, 12); D_STEP(b13, 13); D_STEP(b14, 14); D_STEP(b15, 15);
                int r8[8], r4[4], r2[2];
#pragma unroll
                for (int j = 0; j < 8; ++j) r8[j] = (b3 ? d[j + 8] : d[j]) + __builtin_amdgcn_update_dpp(0, b3 ? d[j] : d[j + 8], 0x128, 0xf, 0xf, false);
#pragma unroll
                for (int j = 0; j < 4; ++j) { const int sd_ = b2 ? r8[j] : r8[j + 4];
                    const int up_ = __builtin_amdgcn_update_dpp(0, sd_, 0x12c, 0xf, 0xf, false), dn_ = __builtin_amdgcn_update_dpp(0, sd_, 0x124, 0xf, 0xf, false);
                    r4[j] = (b2 ? r8[j + 4] : r8[j]) + (b2 ? dn_ : up_); }
#pragma unroll
                for (int j = 0; j < 2; ++j) r2[j] = (b1 ? r4[j + 2] : r4[j]) + __builtin_amdgcn_update_dpp(0, b1 ? r4[j] : r4[j + 2], 0x4e, 0xf, 0xf, false);
                const int tot = (b0_ ? r2[1] : r2[0]) + __builtin_amdgcn_update_dpp(0, b0_ ? r2[0] : r2[1], 0xb1, 0xf, 0xf, false);
                atomicAdd(actp + 16 * i, tot);
            }
#pragma unroll
            for (int k = 0; k < 4; ++k) { xh[k] = xn[k].x; xl[k] = xn[k].y; }
            if (!hasn) break;
            item = itemn; itemn = __builtin_amdgcn_readfirstlane((int)g_); par ^= 1;
        }
    }
}
__device__ __forceinline__ void phase_act_finalize(const Args& a, int gw, int ngw, int lane) {
    const int* ACTI = (const int*)(AWS + WS_STV); unsigned char* AQ8 = AWS + WS_STV + 8 * MiB; float* SAF = (float*)(AWS + WS_RB); int* AQSI = (int*)(AWS + WS_RS);
    const float* SDN = (const float*)(AWS + WS_SDN); const float* SUP = (const float*)(AWS + WS_SUP); const float* GATE = (const float*)(AWS + WS_GATE); const float* XS = (const float*)(AWS + WS_XS); const int* XSUM = (const int*)(AWS + WS_XSUM);
    const int* IDX = (const int*)(AWS + WS_IDX);
    for (int t = gw; t < T_TOK; t += 2 * ngw) {
        const bool has1 = t + ngw < T_TOK; const int t1 = has1 ? t + ngw : t;
        const int e0 = IDX[(size_t)t * 128 + lane], e1 = IDX[(size_t)t * 128 + 64 + lane], f0 = IDX[(size_t)t1 * 128 + lane], f1 = IDX[(size_t)t1 * 128 + 64 + lane];
        const float g0 = GATE[(size_t)t * 128 + lane], g1 = GATE[(size_t)t * 128 + 64 + lane], h0 = GATE[(size_t)t1 * 128 + lane], h1 = GATE[(size_t)t1 * 128 + 64 + lane];
        const int S0 = ACTI[(size_t)t * 128 + lane], S1 = ACTI[(size_t)t * 128 + 64 + lane], R0 = ACTI[(size_t)t1 * 128 + lane], R1 = ACTI[(size_t)t1 * 128 + 64 + lane];
        const float xs = XS[t], ys = XS[t1]; const int xsum = XSUM[t], ysum = XSUM[t1];
        const float sd0 = SDN[e0], sd1 = SDN[e1], su0 = SUP[e0], su1 = SUP[e1], td0 = SDN[f0], td1 = SDN[f1], tu0 = SUP[f0], tu1 = SUP[f1];
        const float a0 = pg8::gelu_t((float)(2 * S0 + xsum) * 0.5f * (sd0 * xs)) * g0 * su0, a1 = pg8::gelu_t((float)(2 * S1 + xsum) * 0.5f * (sd1 * xs)) * g1 * su1;
        const float c0 = pg8::gelu_t((float)(2 * R0 + ysum) * 0.5f * (td0 * ys)) * h0 * tu0, c1 = pg8::gelu_t((float)(2 * R1 + ysum) * 0.5f * (td1 * ys)) * h1 * tu1;
        float ma = fmaxf(fabsf(a0), fabsf(a1)), mc = fmaxf(fabsf(c0), fabsf(c1));
#pragma unroll
        for (int o = 1; o < 64; o <<= 1) { ma = fmaxf(ma, __shfl_xor(ma, o)); mc = fmaxf(mc, __shfl_xor(mc, o)); }
        const float ia = ma > 0.f ? 127.0f / ma : 0.f, ic = mc > 0.f ? 127.0f / mc : 0.f;
        const int q0 = (int)rintf(a0 * ia), q1 = (int)rintf(a1 * ia), r0 = (int)rintf(c0 * ic), r1 = (int)rintf(c1 * ic); int qs = q0 + q1, rs = r0 + r1;
#pragma unroll
        for (int o = 1; o < 64; o <<= 1) { qs += __shfl_xor(qs, o); rs += __shfl_xor(rs, o); }
        AQ8[(size_t)t * 128 + lane] = (unsigned char)(q0 & 255); AQ8[(size_t)t * 128 + 64 + lane] = (unsigned char)(q1 & 255);
        if (lane == 0) { SAF[t] = ma * (1.0f / 127.0f); AQSI[t] = qs; }
        if (has1) { AQ8[(size_t)t1 * 128 + lane] = (unsigned char)(r0 & 255); AQ8[(size_t)t1 * 128 + 64 + lane] = (unsigned char)(r1 & 255);
            if (lane == 0) { SAF[t1] = mc * (1.0f / 127.0f); AQSI[t1] = rs; } }
    }
}
#ifndef FIN_CALL
#define FIN_CALL phase_act_finalize(a, gw, ngw, lane)
#endif
#ifndef P1_COLS
#define P1_COLS 1
#endif
#ifndef GATHER_S
#define GATHER_S 5
#endif
constexpr int P2C_CTR = WD_CTR + 128 + 8 * 64;
__device__ __forceinline__ void phase_gather_p2c(const Args& a, LAS unsigned char* lds, int tid, int lane, int wave) {
    static_assert(TB_U == 4 && UP_SLICED, "column-sliced pass 2: 4-bit slice-major up table");
    const unsigned char* UPS = AWS + WS_UP; const int* IDX = (const int*)(AWS + WS_IDX); const float* ACT = (const float*)(AWS + WS_STV); const unsigned char* AQ8 = AWS + WS_STV + 8 * MiB; const float* SAF = (const float*)(AWS + WS_RB); const int* AQSI = (const int*)(AWS + WS_RS);
    const bf16* HBp = (const bf16*)(AWS + WS_HB); bf16* U = (bf16*)(AWS + WS_MIX); float* SQ = (float*)(AWS + WS_FA);
    unsigned* ctrb = (unsigned*)(AWS + WS_CTL) + P2C_CTR;
    const int g = lane >> 4, l16 = lane & 15;
    const int myslice = (int)((unsigned)__builtin_amdgcn_s_getreg((3 << 11) | 20) & 7u);
#define C_LOAD(B, k) do { const unsigned o_ = (unsigned)lidx[(k)] + lo16; B = *(const v4u*)(ups + o_); } while (0)
#define C_W(W, J) do { const unsigned w__ = (W); iacc[(J)] = __builtin_amdgcn_sdot4((int)w__, a4, iacc[(J)], false); iacc[16 + (J)] = __builtin_amdgcn_sdot4((int)(w__ & 0x0f0f0f0fu), a4, iacc[16 + (J)], false); } while (0)
#define C_T4(BA, BB, BC, BD, K) do { const unsigned wa_ = BA[K], wb_ = BB[K], wc_ = BC[K], wd_ = BD[K]; \
        const unsigned tl01_ = __builtin_amdgcn_perm(wb_, wa_, 0x05010400u), th01_ = __builtin_amdgcn_perm(wb_, wa_, 0x07030602u), tl23_ = __builtin_amdgcn_perm(wd_, wc_, 0x05010400u), th23_ = __builtin_amdgcn_perm(wd_, wc_, 0x07030602u); \
        C_W(__builtin_amdgcn_perm(tl23_, tl01_, 0x05040100u), 4 * (K)); C_W(__builtin_amdgcn_perm(tl23_, tl01_, 0x07060302u), 4 * (K) + 1); \
        C_W(__builtin_amdgcn_perm(th23_, th01_, 0x05040100u), 4 * (K) + 2); C_W(__builtin_amdgcn_perm(th23_, th01_, 0x07060302u), 4 * (K) + 3); } while (0)
#define C_GROUP(BA, BB, BC, BD, G, KB) do { const int a4 = ((const LAS int*)la4)[(G)]; \
        C_T4(BA, BB, BC, BD, 0); C_T4(BA, BB, BC, BD, 1); C_T4(BA, BB, BC, BD, 2); C_T4(BA, BB, BC, BD, 3); \
        { const int kn_ = (8 * i + 8 + (KB)) & 127; const v4u idq_ = *(const LAS v4u*)(lidx + kn_); BA = *(const v4u*)(ups + (idq_.x + lo16)); BB = *(const v4u*)(ups + (idq_.y + lo16)); BC = *(const v4u*)(ups + (idq_.z + lo16)); BD = *(const v4u*)(ups + (idq_.w + lo16)); } } while (0)
#define C_GROUPL(BA, BB, BC, BD, G) do { const int a4 = ((const LAS int*)la4c)[(G)]; \
        C_T4(BA, BB, BC, BD, 0); C_T4(BA, BB, BC, BD, 1); C_T4(BA, BB, BC, BD, 2); C_T4(BA, BB, BC, BD, 3); } while (0)
#pragma unroll 1
    for (int ks = 0; ks < 8; ++ks) {
        const int s = (myslice + ks) & 7; unsigned* ctr = ctrb + s * 64;
        const unsigned char* ups = UPS + (size_t)s * NEXP * 256; const unsigned lo16 = 16u * (unsigned)l16;
        int item, itemn; { unsigned g_ = 0u, h_ = 0u; if (lane == 0) { g_ = atomicAdd(ctr, 1u); h_ = atomicAdd(ctr, 1u); } item = __builtin_amdgcn_readfirstlane((int)g_); itemn = __builtin_amdgcn_readfirstlane((int)h_); }
        if (item >= T_TOK / 4) continue;
        int par = 0; float sa; int aqs; v4u b0, b1, b2, b3, b4, b5, b6, b7;
#define C_STAGE(ev, av, P) do { LAS int* li_ = lidx0 + (P) * 640; LAS unsigned char* la_ = (LAS unsigned char*)(li_ + 512); float amax_ = 0.f; \
            _Pragma("unroll") for (int j = 0; j < 8; ++j) { li_[g * 128 + l16 + 16 * j] = ev[j] << 8; amax_ = fmaxf(amax_, fabsf(av[j])); } \
            amax_ = rowmax16_f(amax_); sa = amax_ * (1.0f / 127.0f); const float ainv_ = amax_ > 0.f ? 127.0f / amax_ : 0.f; aqs = 0; \
            _Pragma("unroll") for (int j = 0; j < 8; ++j) { const int q_ = (int)rintf(av[j] * ainv_); aqs += q_; la_[g * 128 + l16 + 16 * j] = (unsigned char)(q_ & 255); } \
            aqs = rowsum16_i(aqs); } while (0)
        LAS int* lidx0 = (LAS int*)(lds + wave * 5120);
#define C_STAGE2(ev, aqw, sav, aqsv, P) do { LAS int* li_ = lidx0 + (P) * 640; LAS unsigned char* la_ = (LAS unsigned char*)(li_ + 512); \
            _Pragma("unroll") for (int j = 0; j < 8; ++j) li_[g * 128 + l16 + 16 * j] = ev[j] << 8; \
            *(LAS v2u*)(la_ + g * 128 + 8 * l16) = (aqw); sa = (sav); aqs = (aqsv); } while (0)
        { int ev[8]; float av[8]; const int t_ = item * 4 + g;
#pragma unroll
          for (int j = 0; j < 8; ++j) { ev[j] = IDX[(size_t)t_ * 128 + l16 + 16 * j]; av[j] = ACT[(size_t)t_ * 128 + l16 + 16 * j]; }
          if (P1_COLS) { const v2u aqw_ = *(const v2u*)(AQ8 + (size_t)t_ * 128 + 8 * l16); C_STAGE2(ev, aqw_, SAF[t_], AQSI[t_], 0); }
          else C_STAGE(ev, av, 0); }
        { LAS int* lidx = lidx0 + g * 128; C_LOAD(b0, 0); C_LOAD(b1, 1); C_LOAD(b2, 2); C_LOAD(b3, 3); C_LOAD(b4, 4); C_LOAD(b5, 5); C_LOAD(b6, 6); C_LOAD(b7, 7); }
        for (;;) {
            unsigned g_ = 0u; if (lane == 0) g_ = atomicAdd(ctr, 1u);
            const bool hasn = itemn < T_TOK / 4; const int t = item * 4 + g, tn = (hasn ? itemn : item) * 4 + g;
            int lanev = lane; asm volatile("" : "+v"(lanev)); const int l16v = lanev & 15;
            int evn[8]; float avn[8];
#pragma unroll
            for (int j = 0; j < 8; ++j) { evn[j] = IDX[(size_t)tn * 128 + l16v + 16 * j]; if (!P1_COLS) avn[j] = ACT[(size_t)tn * 128 + l16v + 16 * j]; }
            v2u aqwn = (v2u){0u, 0u}; float san = 0.f; int aqsn = 0;
            if (P1_COLS) { aqwn = *(const v2u*)(AQ8 + (size_t)tn * 128 + 8 * l16v); san = SAF[tn]; aqsn = AQSI[tn]; }
            const size_t cb = (size_t)t * DM + 512 * s + 16 * l16v;
            LAS int* lidx = lidx0 + par * 640 + g * 128; const LAS unsigned char* la4c = (const LAS unsigned char*)(lidx0 + par * 640 + 512) + g * 128; const LAS unsigned char* la4 = la4c;
            const float sa_c = sa; const int aqs_c = aqs;
            int iacc[32];
#pragma unroll
            for (int q = 0; q < 32; ++q) iacc[q] = 0;
#pragma unroll 1
            for (int i = 0; i < 8; ++i) { C_GROUP(b0, b1, b2, b3, 2 * i, 0); C_GROUP(b4, b5, b6, b7, 2 * i + 1, 4); }
            const v4u h00 = __builtin_nontemporal_load((const v4u*)(HBp + cb)), h01 = __builtin_nontemporal_load((const v4u*)(HBp + cb + 8)), h10 = __builtin_nontemporal_load((const v4u*)(HBp + cb + 256)), h11 = __builtin_nontemporal_load((const v4u*)(HBp + cb + 264));
#pragma unroll 1
            for (int i = 8; i < 15; ++i) { C_GROUP(b0, b1, b2, b3, 2 * i, 0); C_GROUP(b4, b5, b6, b7, 2 * i + 1, 4); }
            C_GROUPL(b0, b1, b2, b3, 30); C_GROUPL(b4, b5, b6, b7, 31);
            if (P1_COLS) C_STAGE2(evn, aqwn, san, aqsn, par ^ 1); else C_STAGE(evn, avn, par ^ 1);
            { LAS int* lidx = lidx0 + (par ^ 1) * 640 + g * 128; C_LOAD(b0, 0); C_LOAD(b1, 1); C_LOAD(b2, 2); C_LOAD(b3, 3); C_LOAD(b4, 4); C_LOAD(b5, 5); C_LOAD(b6, 6); C_LOAD(b7, 7); }
            const int ioff2 = toff2_of(TB_U) * aqs_c; const float sa2 = 0.5f * sa_c; float q2 = 0.f;
#pragma unroll
            for (int hf = 0; hf < 2; ++hf) { const v4u h0 = hf ? h10 : h00, h1 = hf ? h11 : h01; float uu[16];
#pragma unroll
                for (int k = 0; k < 4; ++k)
#pragma unroll
                    for (int el = 0; el < 4; ++el) { const int c_ = 4 * k + el; const unsigned hw_ = (c_ < 8) ? h0[c_ >> 1] : h1[(c_ - 8) >> 1];
                        const int J_ = 4 * k + 2 * hf + (el >> 1);
                        const int sv_ = (el & 1) ? 2 * ((iacc[J_] - iacc[16 + J_]) >> 4) + aqs_c : 2 * iacc[16 + J_] - ioff2;
                        uu[c_] = (float)sv_ * sa2 + ((c_ & 1) ? bfhi(hw_) : bflo(hw_)); q2 += uu[c_] * uu[c_]; }
                v4u o0, o1; o0.x = pk2(uu[0], uu[1]); o0.y = pk2(uu[2], uu[3]); o0.z = pk2(uu[4], uu[5]); o0.w = pk2(uu[6], uu[7]); o1.x = pk2(uu[8], uu[9]); o1.y = pk2(uu[10], uu[11]); o1.z = pk2(uu[12], uu[13]); o1.w = pk2(uu[14], uu[15]);
                *(v4u*)(U + cb + 256 * hf) = o0; *(v4u*)(U + cb + 256 * hf + 8) = o1; }
            q2 = rowsum16_f(q2);
            if (l16v == 0) atomicAdd(SQ + t, q2);
            if (!hasn) break;
            item = itemn; itemn = __builtin_amdgcn_readfirstlane((int)g_); par ^= 1;
        }
    }
}
__device__ __forceinline__ void phase_final_norm(const Args& a, int gw, int ngw, int lane) {
    const bf16* U = (const bf16*)(AWS + WS_MIX); const float* SQ = (const float*)(AWS + WS_FA);
    for (int t = gw; t < T_TOK; t += ngw) {
        const float rstd = 1.0f / sqrtf(SQ[t] * (1.0f / DM) + EPS); const v4u* ur = (const v4u*)(U + (size_t)t * DM) + lane; float* orow = AOUT + (size_t)t * DM + 8 * lane; const float* gf = AIN(I_GFIN) + 8 * lane;
#pragma unroll
        for (int j = 0; j < 8; ++j) { const v4u w = __builtin_nontemporal_load(ur + 64 * j); const f32x4 g0 = *(const f32x4*)(gf + 512 * j), g1 = *(const f32x4*)(gf + 512 * j + 4);
            __builtin_nontemporal_store((f32x4){bflo(w.x) * rstd * g0.x, bfhi(w.x) * rstd * g0.y, bflo(w.y) * rstd * g0.z, bfhi(w.y) * rstd * g0.w}, (f32x4*)(orow + 512 * j));
            __builtin_nontemporal_store((f32x4){bflo(w.z) * rstd * g1.x, bfhi(w.z) * rstd * g1.y, bflo(w.w) * rstd * g1.z, bfhi(w.w) * rstd * g1.w}, (f32x4*)(orow + 512 * j + 4)); }
    }
}

typedef GAS unsigned gu32;
#define XB_TMO      128
#define XB_XCNT(j)  (256  + 64 * (j))
#define XB_XSUB(j)  (1280 + 64 * (j))
#define XB_XGEN(j)  (2304 + 64 * (j))
#define XB_TOP      3328
#define XB_TOPGEN   3392
#define XCD_BAR_WORDS 3456
#define XB_SPIN_CAP (1u << 18)

__device__ __forceinline__ unsigned xb_ld(unsigned* p)              { return __hip_atomic_load(p, __ATOMIC_RELAXED, __HIP_MEMORY_SCOPE_AGENT); }
__device__ __forceinline__ unsigned xb_add(unsigned* p, unsigned v) { return __hip_atomic_fetch_add(p, v, __ATOMIC_RELAXED, __HIP_MEMORY_SCOPE_AGENT); }
__device__ __forceinline__ unsigned xb_xcc_id() { return (unsigned)__builtin_amdgcn_s_getreg((3 << 11) | 20) & 0xFu; }
#define XB_SPIN(cond, bar) do { unsigned _sp = 0; while (cond) { __builtin_amdgcn_s_sleep(1); \
    if ((++_sp & 255u) == 0u) { if (xb_ld(&(bar)[XB_TMO])) break; if (_sp > XB_SPIN_CAP) { atomicAdd(&(bar)[XB_TMO], 1u); break; } } } } while (0)

struct XcdBarrier {
    unsigned* bar; unsigned x;
    volatile LAS unsigned* st;
};

__device__ __forceinline__ XcdBarrier xcd_barrier_post(unsigned* bar, volatile LAS unsigned* st) {
    XcdBarrier b; b.bar = bar; b.x = xb_xcc_id(); b.st = st;
    if (threadIdx.x == 0) (void)xb_add(&bar[XB_XCNT(b.x)], 1u);
    return b;
}
__device__ __forceinline__ void xcd_barrier_complete(unsigned* bar, unsigned x, unsigned& nloc, unsigned& nx) {
    const unsigned G = gridDim.x * gridDim.y * gridDim.z;
    unsigned sum, cnt, mine, sp = 0u;
    for (;;) {
        sum = 0u; cnt = 0u; mine = 0u;
#pragma unroll
        for (unsigned j = 0; j < 16; ++j) { const unsigned c = xb_ld(&bar[XB_XCNT(j)]); sum += c; cnt += (c > 0u) ? 1u : 0u; mine = (j == x) ? c : mine; }
        if (sum == G) break;
        __builtin_amdgcn_s_sleep(1);
        if ((++sp & 255u) == 0u) { if (xb_ld(&bar[XB_TMO])) break; if (sp > XB_SPIN_CAP) { atomicAdd(&bar[XB_TMO], 1u); break; } }
    }
    nloc = mine > 0u ? mine : 1u; nx = cnt > 0u ? cnt : 1u;
}

__device__ __forceinline__ void xcd_barrier(const XcdBarrier& b) {
    asm volatile("s_waitcnt vmcnt(0)" ::: "memory");
    __syncthreads();
    if (threadIdx.x == 0) {
        unsigned* bar = b.bar;
        __builtin_amdgcn_s_waitcnt(0);
        unsigned nloc = b.st[0], nx = b.st[1];
        if (nloc == 0u) { xcd_barrier_complete(bar, b.x, nloc, nx); b.st[0] = nloc; b.st[1] = nx; }
        const unsigned old = xb_add(&bar[XB_XSUB(b.x)], 1u);
        const unsigned gen = old / nloc;
        if (old + 1u == (gen + 1u) * nloc) {
            __builtin_amdgcn_fence(__ATOMIC_RELEASE, "agent");
            asm volatile("s_waitcnt vmcnt(0)" ::: "memory");
            const unsigned og = xb_add(&bar[XB_TOP], 1u);
            const unsigned tg = og / nx;
            if (og + 1u == (tg + 1u) * nx) xb_add(&bar[XB_TOPGEN], 1u);
            else XB_SPIN(xb_ld(&bar[XB_TOPGEN]) == tg, bar);
            __builtin_amdgcn_fence(__ATOMIC_ACQUIRE, "agent");
            xb_add(&bar[XB_XGEN(b.x)], 1u);
            asm volatile("s_waitcnt vmcnt(0)" ::: "memory");
        } else {
            XB_SPIN(xb_ld(&bar[XB_XGEN(b.x)]) == gen, bar);
            __builtin_amdgcn_fence(__ATOMIC_ACQUIRE, "agent");
            asm volatile("s_waitcnt vmcnt(0)" ::: "memory");
        }
    }
    __syncthreads();
}

#ifndef PHMASK
#define PHMASK 0x3ff
#endif
#define PHE(k) ((PHMASK >> (k)) & 1)
__global__ void __launch_bounds__(NTHREADS, 2) mega(Args a) {
    extern __shared__ __attribute__((aligned(16))) unsigned char lds_raw[];
    LAS unsigned char* lds = (LAS unsigned char*)lds_raw;
    const int tid = threadIdx.x, lane = tid & 63, wave = __builtin_amdgcn_readfirstlane(tid >> 6);
    const int gw = blockIdx.x * NWAVES + wave, ngw = gridDim.x * NWAVES;
    unsigned char* ws = AWS;
    const int lo = KARG(int, 224), hi = KARG(int, 228);
    if (tid < 16) ((LAS unsigned*)(lds + MISC_OFF))[tid] = 0u;
    __syncthreads();
    XcdBarrier bar = xcd_barrier_post((unsigned*)(ws + WS_CTL), (volatile LAS unsigned*)(lds + MISC_OFF));
#define IN(k) (PHE(k) && lo <= (k) && (k) < hi)
#define SEAM(k) do { if ((k) + 1 < hi) xcd_barrier(bar); } while (0)
    if (hi > 1000) cg::this_grid().sync();
#ifndef REPMASK
#define REPMASK 0
#endif
#define REPS(k) for (int rep_ = 0; rep_ < (((REPMASK >> (k)) & 1) ? 2 : 1); ++rep_)
#define RSYNC() do { if (rep_) cg::this_grid().sync(); } while (0)
    { AMP_BEGIN(70);
    if (IN(0)) { AMP_BEGIN(50); REPS(0) { RSYNC(); phase_prologue(a, lds, tid, lane, wave); } AMP_END(50); SEAM(0); }
    AMP_END(70); }
    { AMP_BEGIN(71);
    if (IN(1)) { REPS(1) { RSYNC();
        pg8::Gemm g{(const pg8::bf16_t*)(ws + WS_A1), (const pg8::bf16_t*)(ws + WS_WIN), T_TOK, NZ, DM}; pg8::StaticOrder S; S.init(T_TOK, NZ, gridDim.x, blockIdx.x);
        pg8::EpiZ E{(pg8::bf16_t*)(ws + WS_Z), (pg8::bf16_t*)(ws + WS_ZS5), (pg8::f32x2v*)(ws + WS_STV)};
        pg8::gemm_phase<pg8::EpiZ, pg8::StaticOrder, true, true>(lds, g, S, E); }
        SEAM(1);
    }
    AMP_END(71); }
    { AMP_BEGIN(72);
    if (IN(2)) {
#define PH2_S5() do { if (gridDim.x == 256) { const int u = (blockIdx.x & 7) * 32 + (blockIdx.x >> 3);    \
              s5_unit(a, lds, u >> 1, (u & 1) * 2, tid, lane, wave); } \
            else for (int u = blockIdx.x; u < 2 * NG; u += gridDim.x) s5_unit(a, lds, u >> 1, (u & 1) * 2, tid, lane, wave); } while (0)
#define PH2_GM() do { if (gridDim.x == 256) { for (int j = 0; j < 4; ++j) gmlp_unit(a, lds, (blockIdx.x >> 3) * 4 + j, blockIdx.x & 7, j == 0, tid, lane, wave); }    \
            else for (int u = blockIdx.x; u < 1024; u += gridDim.x) gmlp_unit(a, lds, u >> 3, u & 7, true, tid, lane, wave); } while (0)
        AMP_BEGIN(62);
        { AMP_BEGIN(10); PH2_S5(); AMP_END(10); }
#if (REPMASK >> 10) & 1
        cg::this_grid().sync(); PH2_S5();
#endif
        { AMP_BEGIN(14); PH2_GM(); AMP_END(14); }
#if (REPMASK >> 11) & 1
        cg::this_grid().sync(); PH2_GM();
#endif
        SEAM(2);
        AMP_END(62);
    }
    AMP_END(72); }
    { AMP_BEGIN(73);
    if (IN(3)) { REPS(3) { RSYNC();
        pg8::Gemm g{(const pg8::bf16_t*)(ws + WS_YS5), (const pg8::bf16_t*)(ws + WS_WGLU), T_TOK, 2048, 2048}; pg8::StaticOrder S; S.init(T_TOK, 2048, gridDim.x, blockIdx.x);
        pg8::EpiGlu E{(const pg8::bf16_t*)(ws + WS_YS5), (pg8::bf16_t*)(ws + WS_MIX), (float*)(ws + WS_RA)};
        pg8::gemm_phase<pg8::EpiGlu, pg8::StaticOrder, true, false>(lds, g, S, E); }
        SEAM(3);
    }
    AMP_END(73); }
    { AMP_BEGIN(75);
    if (IN(5)) { REPS(5) { RSYNC();
        pg8::Gemm g{(const pg8::bf16_t*)(ws + WS_MIX), (const pg8::bf16_t*)(ws + WS_WOUT), T_TOK, DM, DM}; pg8::StaticOrder S; S.init(T_TOK, DM, gridDim.x, blockIdx.x);
        {
            const float* SA = (const float*)(ws + WS_RA); const float* SB = (const float*)(ws + WS_RB); float* FA = (float*)(ws + WS_FA); float* FB = (float*)(ws + WS_FB); pg8::Unit uu;
            for (int i = 0; S.next(i, uu); ++i) if (tid < 256) { const int row = uu.pm * 256 + tid; const float va = SA[row] * (1.0f / 2048.0f) + EPS, vb = SB[row] * (1.0f / 2048.0f) + EPS; FA[row] = sqrtf(vb / va); ((LAS float*)(lds + 131072))[(i & 7) * 256 + tid] = sqrtf(vb / va); FB[row] = 1.0f / sqrtf(vb); }
            asm volatile("s_waitcnt vmcnt(0)" ::: "memory"); __syncthreads(); }
        pg8::EpiHB E{(pg8::bf16_t*)(ws + WS_HB), AIN(I_X), (unsigned)(size_t)(lds + 131072), (const float*)(ws + WS_FB), (float*)(ws + WS_RS)};
        pg8::gemm_phase<pg8::EpiHB, pg8::StaticOrder, true, true>(lds, g, S, E); }
        SEAM(5);
    }
    AMP_END(75); }
    { AMP_BEGIN(77);
    if (IN(7)) { AMP_BEGIN(57); REPS(7) { RSYNC();
        pg8::Gemm g{(const pg8::bf16_t*)(ws + WS_HB), (const pg8::bf16_t*)(ws + WS_WQ), T_TOK, 2048, DM}; pg8::StaticOrder S; S.init(T_TOK, 2048, gridDim.x, blockIdx.x);
        pg8::EpiBf16Out E{(pg8::bf16_t*)(ws + WS_Z), 2048, (const float*)(ws + WS_RS)};
        pg8::gemm_phase<pg8::EpiBf16Out, pg8::StaticOrder, true, true>(lds, g, S, E); }
        AMP_END(57);
        SEAM(7);
    }
    AMP_END(77); }
    { AMP_BEGIN(78);
    if (IN(8)) { AMP_BEGIN(58);
        if (GATHER_S == 5 && P1_COLS) { v4u* z_ = (v4u*)(ws + WS_STV); for (int i_ = blockIdx.x * NTHREADS + tid; i_ < T_TOK * 128 / 4; i_ += gridDim.x * NTHREADS) z_[i_] = (v4u){0u, 0u, 0u, 0u}; }
        REPS(8) { RSYNC(); phase_topk(a, lds, tid, lane, wave); } AMP_END(58); SEAM(8); }
    AMP_END(78); }
    { AMP_BEGIN(79);
    #ifdef PG_LOADONLY
    if (IN(9)) { phase_gather<true>(a, lds, tid, lane, wave); __syncthreads(); }
#endif
#ifndef GATHER_W
#define GATHER_W 0
#endif
#ifndef GATHER_S
#define GATHER_S 5
#endif
    if (IN(9)) { AMP_BEGIN(59); if (GATHER_S == 5) { for (int i_ = blockIdx.x * NTHREADS + tid; i_ < T_TOK; i_ += gridDim.x * NTHREADS) ((float*)(ws + WS_FA))[i_] = 0.f;
            { AMP_BEGIN(91); if (P1_COLS) { phase_gather_p1c(a, lds, tid, lane, wave); xcd_barrier(bar); FIN_CALL; } else phase_gather_p1s(a, lds, tid, lane, wave); xcd_barrier(bar); AMP_END(91); } { AMP_BEGIN(92); phase_gather_p2c(a, lds, tid, lane, wave); xcd_barrier(bar); AMP_END(92); } { AMP_BEGIN(93); phase_final_norm(a, gw, ngw, lane); AMP_END(93); } } else if (GATHER_S == 4) { { AMP_BEGIN(91); phase_gather_p1s(a, lds, tid, lane, wave); xcd_barrier(bar); AMP_END(91); } { AMP_BEGIN(92); phase_gather_wd<2, false>(a, lds, tid, lane, wave); AMP_END(92); } } else if (GATHER_S == 3) { phase_gather_wd<1>(a, lds, tid, lane, wave); xcd_barrier(bar); phase_gather_wd<2>(a, lds, tid, lane, wave); } else if (GATHER_S == 2) phase_gather_ws(a, lds, tid, lane, wave); else if (GATHER_S == 1) phase_gather_s(a, lds, tid, lane, wave); else if (GATHER_W) phase_gather_w(a, lds, tid, lane, wave); else phase_gather<false>(a, lds, tid, lane, wave); AMP_END(59); }
    AMP_END(79); }
#undef IN
#undef SEAM
}

#ifndef ONE_LAUNCH
#define ONE_LAUNCH 1
#endif
extern "C" void kernel_launch(void* const* d_in, const int* in_sizes, int n_in, void* d_out, int out_size, void* d_ws, size_t ws_size, hipStream_t stream) {
    static int grid = 0;
    if (grid == 0) {
        if (n_in != 26 || out_size != T_TOK * DM || ws_size < WS_END) { fprintf(stderr, "kernel_launch: unexpected shapes: n_in %d out %d ws %zu\n", n_in, out_size, ws_size); grid = -1; return; }
        int dev = 0, cus = 0;
        if (hipGetDevice(&dev) != hipSuccess || hipDeviceGetAttribute(&cus, hipDeviceAttributeMultiprocessorCount, dev) != hipSuccess) { grid = -1; return; }
        if (hipFuncSetAttribute((const void*)mega, hipFuncAttributeMaxDynamicSharedMemorySize, LDS_BYTES) != hipSuccess) { fprintf(stderr, "kernel_launch: hipFuncSetAttribute failed\n"); grid = -1; return; }
        int per_cu = 0;
        if (hipOccupancyMaxActiveBlocksPerMultiprocessor(&per_cu, (const void*)mega, NTHREADS, LDS_BYTES) != hipSuccess || per_cu < 1) { fprintf(stderr, "kernel_launch: occupancy query says %d blocks per CU\n", per_cu); }
        (void)hipGetLastError();
        grid = cus;
        if (grid < 128) { fprintf(stderr, "kernel_launch: %d CUs: the GEMM_out row-factor table holds 8 units per workgroup (needs >= 128 workgroups)\n", grid); grid = -1; return; }
    }
    if (grid < 0) return;
    if (hipMemsetAsync((char*)d_ws + WS_CTL, 0, CTL_ZERO_BYTES, stream) != hipSuccess) { fprintf(stderr, "kernel_launch: memset failed\n"); return; }
    Args a{};
    for (int i = 0; i < 26; ++i) a.in[i] = (const float*)d_in[i];
    a.out = (float*)d_out; a.ws = (unsigned char*)d_ws;
#if ONE_LAUNCH
    a.ph_lo = 0; a.ph_hi = NPH; void* args[] = {&a};
    hipError_t e = hipLaunchCooperativeKernel((const void*)mega, dim3(grid), dim3(NTHREADS), args, LDS_BYTES, stream);
    if (e != hipSuccess) fprintf(stderr, "cooperative launch failed: %s (grid %d)\n", hipGetErrorString(e), grid);
#else
    for (int p = 0; p < NPH; ++p) { a.ph_lo = p; a.ph_hi = p + 1; hipLaunchKernelGGL(mega, dim3(grid), dim3(NTHREADS), LDS_BYTES, stream, a); }
#endif
}
```
